# Optimizing an MI355X kernel written in HIP

```python
import math
import jax, jax.numpy as jnp
from jax import lax
import numpy as np

D_MODEL = 2048
BATCH = 4
SEQ = 2048
DEPTH = 4
DEC_BATCH = 32
DEC_SEQ = 4
PAST_LEN = 16384
PAGE_SIZE = 128

A_HEADS = 8
A_DK = 128
A_DV = 128
A_KEY_WIDTH = A_HEADS * A_DK
A_WIDTH = A_HEADS * A_DV
HGRN_CHUNK = 64
B_HEADS = 16
B_KV_HEADS = 4
B_GROUP = B_HEADS // B_KV_HEADS
B_HD = 64
B_WIDTH = B_HEADS * B_HD
B_KV_WIDTH = B_KV_HEADS * B_HD
WINDOW = 128
ATTN_SCALE = 1.0 / math.sqrt(B_HD)
NEG_LOGIT = -1e30
LB_FLOOR = 1e-20
N_BUCKETS = 32
MAX_DISTANCE = 128
MIX_WIDTH = A_WIDTH + B_WIDTH
SPLIT_POINTS = (A_KEY_WIDTH,
                2 * A_KEY_WIDTH,
                2 * A_KEY_WIDTH + A_WIDTH,
                2 * A_KEY_WIDTH + 2 * A_WIDTH,
                2 * A_KEY_WIDTH + 2 * A_WIDTH + B_WIDTH,
                2 * A_KEY_WIDTH + 2 * A_WIDTH + B_WIDTH + B_KV_WIDTH)
IN_WIDTH = 2 * A_KEY_WIDTH + 2 * A_WIDTH + B_WIDTH + 2 * B_KV_WIDTH
D_FF = ((8 * D_MODEL // 3 + 255) // 256) * 256
RMS_EPS = 1e-6

kernel_name = 'hymba_hgrn2_swa_sink_decoder_step'


def rms_norm(x, g):
    xf = x.astype(jnp.float32)
    y = xf * lax.rsqrt(jnp.mean(xf * xf, axis=-1, keepdims=True) + RMS_EPS)
    return (y * g.astype(jnp.float32)).astype(x.dtype)


def t5_bucket(dist):
    n = np.maximum(dist, 0)
    max_exact = N_BUCKETS // 2
    nf = np.maximum(n, 1).astype(np.float32)
    large = max_exact + (np.log(nf / max_exact) / math.log(MAX_DISTANCE / max_exact)
                         * (N_BUCKETS - max_exact)).astype(np.int32)
    large = np.minimum(large, N_BUCKETS - 1)
    return np.where(n < max_exact, n, large).astype(np.int32)


def relative_bias(table, dist):
    b = table.astype(jnp.float32)[t5_bucket(dist)]
    return jnp.transpose(b, (2, 0, 1)).reshape(B_KV_HEADS, B_GROUP, dist.shape[0], dist.shape[1])


def sink_softmax(s, sink):
    sk = sink.astype(jnp.float32).reshape(B_KV_HEADS, B_GROUP, 1, 1)
    m = jnp.maximum(jnp.max(s, axis=-1, keepdims=True), sk)
    e = jnp.exp(s - m)
    return e / (jnp.sum(e, axis=-1, keepdims=True) + jnp.exp(sk - m))


def hgrn2_scan(q, log_f, k, v, s0):
    bsz, length = q.shape[0], q.shape[1]
    c = min(HGRN_CHUNK, length)
    n = -(-length // c)
    pad = n * c - length

    def blocks(t):
        t = jnp.pad(t, ((0, 0), (0, pad), (0, 0), (0, 0)))
        return t.reshape(bsz, n, c, t.shape[2], t.shape[3]).transpose(1, 0, 3, 2, 4)

    causal = jnp.asarray(np.tril(np.ones((c, c), dtype=bool)))[:, :, None]

    def step(state, inp):
        qc, lfc, kc, vc = inp
        b = jnp.cumsum(lfc, axis=2)
        o_inter = jnp.einsum('bhtk,bhkv->bhtv', qc * jnp.exp(b), state)
        diff = b[:, :, :, None, :] - b[:, :, None, :, :]
        decay = jnp.where(causal, jnp.exp(jnp.where(causal, diff, 0.0)), 0.0)
        a = jnp.einsum('bhtk,bhtsk,bhsk->bhts', qc, decay, kc)
        o_intra = jnp.einsum('bhts,bhsv->bhtv', a, vc)
        b_last = b[:, :, -1:, :]
        new_state = (jnp.exp(b_last[:, :, 0, :])[..., None] * state
                     + jnp.einsum('bhsk,bhsv->bhkv', kc * jnp.exp(b_last - b), vc))
        return new_state, o_inter + o_intra

    s_final, o = lax.scan(step, s0, (blocks(q), blocks(log_f), blocks(k), blocks(v)))
    o = o.transpose(1, 0, 3, 2, 4).reshape(bsz, n * c, q.shape[2], v.shape[3])[:, :length]
    return o, s_final


def mixer_inputs(x, norm_g, w_in, lb, qn_g, kn_g):
    bsz, length, _ = x.shape
    u = rms_norm(x, norm_g) @ w_in
    qa, fa, ia, ga, qb, kb, vb = jnp.split(u, SPLIT_POINTS, axis=-1)
    z = fa.astype(jnp.float32)
    log_lb = jnp.log(jnp.maximum(lb, LB_FLOOR))
    log_f = jnp.logaddexp(log_lb, jnp.log1p(-lb) + jax.nn.log_sigmoid(z))
    ka = (1.0 - lb) * jax.nn.sigmoid(-z)
    qa = jax.nn.silu(qa.astype(jnp.float32))
    a_shape = (bsz, length, A_HEADS, A_DK)
    hgrn = (qa.reshape(a_shape), log_f.reshape(a_shape), ka.reshape(a_shape),
            ia.astype(jnp.float32).reshape(bsz, length, A_HEADS, A_DV), ga)
    qb = rms_norm(qb.reshape(bsz, length, B_HEADS, B_HD), qn_g)
    kb = rms_norm(kb.reshape(bsz, length, B_KV_HEADS, B_HD), kn_g)
    vb = vb.reshape(bsz, length, B_KV_HEADS, B_HD)
    return hgrn, (qb, kb, vb)


def hgrn2_output(o, gn, ga, dtype):
    bsz, length = o.shape[0], o.shape[1]
    gate = jax.nn.silu(ga.astype(jnp.float32)).reshape(bsz, length, A_HEADS, A_DV)
    return (rms_norm(o, gn) * gate).reshape(bsz, length, A_WIDTH).astype(dtype)


def swa_prompt(q, k, v, sink, bias, mask):
    bsz, length = q.shape[0], q.shape[1]
    nb = length // WINDOW
    qb = q.reshape(bsz, nb, WINDOW, B_KV_HEADS, B_GROUP, B_HD)

    def band(t):
        t = t.reshape(bsz, nb, WINDOW, B_KV_HEADS, B_HD)
        prev = jnp.concatenate([jnp.zeros_like(t[:, :1]), t[:, :-1]], axis=1)
        return jnp.concatenate([prev, t], axis=2)

    kb, vb = band(k), band(v)
    s = jnp.einsum('bnqhgd,bnshd->bnhgqs', qb, kb, preferred_element_type=jnp.float32) * ATTN_SCALE + bias
    s = jnp.where(mask[None, :, None, None], s, NEG_LOGIT)
    p = sink_softmax(s, sink)
    o = jnp.einsum('bnhgqs,bnshd->bnqhgd', p.astype(v.dtype), vb)
    return o.reshape(bsz, length, B_WIDTH)


def swa_sample(q, k, v, ck, cv, sink, bias, mask):
    bsz, length = q.shape[0], q.shape[1]
    w = ck.shape[1]
    kall = jnp.concatenate([ck.astype(k.dtype), k], axis=1)
    vall = jnp.concatenate([cv.astype(v.dtype), v], axis=1)
    q5 = q.reshape(bsz, length, B_KV_HEADS, B_GROUP, B_HD)
    s = jnp.einsum('blhgd,bshd->bhgls', q5, kall, preferred_element_type=jnp.float32) * ATTN_SCALE + bias
    s = jnp.where(mask, s, NEG_LOGIT)
    p = sink_softmax(s, sink)
    o = jnp.einsum('bhgls,bshd->blhgd', p.astype(vall.dtype), vall).reshape(bsz, length, B_WIDTH)
    return o, kall[:, -w:], vall[:, -w:]


def swiglu(x, g, wg, wu, wd):
    h = rms_norm(x, g)
    return x + (jax.nn.silu(h @ wg) * (h @ wu)) @ wd


def setup_inputs(seed: int = 0) -> dict:
    key = jax.random.key(seed)
    ks = jax.random.split(key, 20)
    w = min(WINDOW, PAST_LEN)

    def nrm(k, shape, scale):
        return scale * jax.random.normal(k, shape, jnp.float32)

    return {
        'x_prompt': nrm(ks[0], (BATCH, SEQ, D_MODEL), 1.0),
        'x_sample': nrm(ks[1], (DEC_BATCH, DEC_SEQ, D_MODEL), 1.0),
        'cache_k': nrm(ks[2], (DEPTH, DEC_BATCH, w, B_KV_HEADS, B_HD), 1.0),
        'cache_v': nrm(ks[3], (DEPTH, DEC_BATCH, w, B_KV_HEADS, B_HD), 1.0),
        'state_hgrn': nrm(ks[4], (DEPTH, DEC_BATCH, A_HEADS, A_DK, A_DV), 0.5),
        'norm_mix': 1.0 + nrm(ks[5], (DEPTH, D_MODEL), 0.02),
        'w_in': nrm(ks[6], (DEPTH, D_MODEL, IN_WIDTH), D_MODEL ** -0.5),
        'lower_bounds': 1.0 + nrm(ks[7], (DEPTH, A_KEY_WIDTH), 0.1),
        'hgrn_norm': 1.0 + nrm(ks[8], (DEPTH, A_DV), 0.02),
        'q_norm': 1.0 + nrm(ks[9], (DEPTH, B_HD), 0.02),
        'k_norm': 1.0 + nrm(ks[10], (DEPTH, B_HD), 0.02),
        'attn_sinks': nrm(ks[11], (DEPTH, B_HEADS), 0.5),
        'rel_bias_table': nrm(ks[12], (N_BUCKETS, B_HEADS), 0.5),
        'w_out': nrm(ks[13], (DEPTH, MIX_WIDTH, D_MODEL), MIX_WIDTH ** -0.5),
        'norm_ffn': 1.0 + nrm(ks[14], (DEPTH, D_MODEL), 0.02),
        'w_gate': nrm(ks[15], (DEPTH, D_MODEL, D_FF), D_MODEL ** -0.5),
        'w_up': nrm(ks[16], (DEPTH, D_MODEL, D_FF), D_MODEL ** -0.5),
        'w_down': nrm(ks[17], (DEPTH, D_FF, D_MODEL), D_FF ** -0.5),
    }


def reference(x_prompt, x_sample, cache_k, cache_v, state_hgrn, norm_mix, w_in, lower_bounds,
              hgrn_norm, q_norm, k_norm, attn_sinks, rel_bias_table, w_out, norm_ffn,
              w_gate, w_up, w_down):
    p_lb = jax.nn.softmax(lower_bounds.astype(jnp.float32), axis=0)
    lb_all = jnp.cumsum(p_lb, axis=0) - p_lb[0:1]

    bp, seq = x_prompt.shape[0], x_prompt.shape[1]
    nb = seq // WINDOW
    dist_p = (WINDOW + np.arange(WINDOW))[:, None] - np.arange(2 * WINDOW)[None, :]
    key_pos = np.arange(nb)[:, None, None] * WINDOW - WINDOW + np.arange(2 * WINDOW)[None, None, :]
    mask_p = jnp.asarray(((dist_p >= 0) & (dist_p < WINDOW))[None] & (key_pos >= 0))
    bias_p = relative_bias(rel_bias_table, dist_p)
    wp = min(WINDOW, seq)

    bd, ld = x_sample.shape[0], x_sample.shape[1]
    wd = cache_k.shape[2]
    dist_s = (wd + np.arange(ld))[:, None] - np.arange(wd + ld)[None, :]
    mask_s = jnp.asarray((dist_s >= 0) & (dist_s < WINDOW))
    bias_s = relative_bias(rel_bias_table, dist_s)

    xp, xs = x_prompt, x_sample
    pk, pv, ps, sk, sv, ss = [], [], [], [], [], []
    for l in range(DEPTH):
        lb = lb_all[l]
        (qa, lf, ka, va, ga), (qb, kb, vb) = mixer_inputs(xp, norm_mix[l], w_in[l], lb, q_norm[l], k_norm[l])
        oa, st_p = hgrn2_scan(qa, lf, ka, va, jnp.zeros((bp, A_HEADS, A_DK, A_DV), jnp.float32))
        oa = hgrn2_output(oa, hgrn_norm[l], ga, xp.dtype)
        ob = swa_prompt(qb, kb, vb, attn_sinks[l], bias_p, mask_p)
        xp = xp + jnp.concatenate([oa, ob.astype(xp.dtype)], axis=-1) @ w_out[l]
        xp = swiglu(xp, norm_ffn[l], w_gate[l], w_up[l], w_down[l])
        pk.append(kb[:, -wp:])
        pv.append(vb[:, -wp:])
        ps.append(st_p)
        (qa, lf, ka, va, ga), (qb, kb, vb) = mixer_inputs(xs, norm_mix[l], w_in[l], lb, q_norm[l], k_norm[l])
        oa, st_s = hgrn2_scan(qa, lf, ka, va, state_hgrn[l].astype(jnp.float32))
        oa = hgrn2_output(oa, hgrn_norm[l], ga, xs.dtype)
        ob, nk, nv = swa_sample(qb, kb, vb, cache_k[l], cache_v[l], attn_sinks[l], bias_s, mask_s)
        xs = xs + jnp.concatenate([oa, ob.astype(xs.dtype)], axis=-1) @ w_out[l]
        xs = swiglu(xs, norm_ffn[l], w_gate[l], w_up[l], w_down[l])
        sk.append(nk)
        sv.append(nv)
        ss.append(st_s)

    prompt_k, prompt_v, prompt_state = jnp.stack(pk), jnp.stack(pv), jnp.stack(ps)
    sample_k, sample_v, sample_state = jnp.stack(sk), jnp.stack(sv), jnp.stack(ss)
    return (xp, xs, prompt_k, prompt_v, prompt_state, sample_k, sample_v, sample_state)
```

```cpp
#include <hip/hip_runtime.h>
#include <hip/hip_cooperative_groups.h>
#include <cstdio>
#include <cstdint>
namespace cg = cooperative_groups;
#ifndef PROBE_MIX2
#define PROBE_MIX2 0
#endif
#ifndef PROBE_IN2
#define PROBE_IN2 0
#endif
#ifndef PROBE_ND
#define PROBE_ND 0
#endif
#ifndef PROBE_PRO2
#define PROBE_PRO2 0
#endif
#ifndef PROBE_SYNC2
#define PROBE_SYNC2 0
#endif


#define LAS __attribute__((address_space(3)))
typedef unsigned short bf16_t;
typedef short bf16x8 __attribute__((ext_vector_type(8)));
typedef float f32x4 __attribute__((ext_vector_type(4)));
typedef float f32x2 __attribute__((ext_vector_type(2)));
typedef unsigned u32x4 __attribute__((ext_vector_type(4)));
typedef unsigned u32x2 __attribute__((ext_vector_type(2)));

constexpr int DM = 2048, NPROMPT = 8192, NSAMP = 128, MR = NPROMPT + NSAMP  , MP = 8448  ;
constexpr int INW = 5632, FFW = 5632, DEPTH = 4, SEQ = 2048;
constexpr float EPS = 1e-6f, SSQ_SCALE = 1048576.f, SSQ_INV = 1.f / 1048576.f;
constexpr size_t O_YP = 0, O_YS = 16777216, O_PK = 17039360, O_PV = 17563648, O_PS = 18087936, O_SK = 20185088, O_SV = 24379392, O_SS = 28573696;
constexpr size_t MiB = 1u << 20;
constexpr size_t WS_LB = 0, WS_BAR = 720896  , WS_CNT = 737280  , WS_SSQ = 65536, WS_W = 1 * MiB, W_IN_OFF = 0, W_OUT_OFF = 22 * MiB, W_GU_OFF = 30 * MiB, W_DN_OFF = 74 * MiB, W_LAYER = 96 * MiB;
constexpr size_t WS_X = 385 * MiB, WS_XB = 451 * MiB, WS_U = 484 * MiB, WS_LF = 575 * MiB, WS_MIX = 608 * MiB, WS_ACT = 641 * MiB, WS_END = 732 * MiB;
constexpr int LDS_BYTES = 147456;
constexpr int CVT_QIN = 3000;
constexpr int CVT_SPLIT = 32 * 176 + 32 * 64, CVT_ALL = 32 * 176 * 3 + 32 * 64 + 88 * 64;


struct Params {
    const float *x_prompt, *x_sample, *cache_k, *cache_v, *state, *norm_mix, *w_in, *lower_bounds, *hgrn_norm, *q_norm, *k_norm, *sinks, *rel_bias, *w_out, *norm_ffn, *w_gate, *w_up, *w_down;
    float* out; unsigned char* ws;
    int ph_lo, ph_hi;
};

__device__ __forceinline__ int tid_opaque() { int t = threadIdx.x; asm volatile("" : "+v"(t)); return t; }
__device__ __forceinline__ int bid_opaque() { int t = blockIdx.x; asm volatile("" : "+s"(t)); return t; }
__device__ __forceinline__ float bf2f(unsigned u16) { return __uint_as_float(u16 << 16); }
typedef __bf16 bf16x2_t __attribute__((ext_vector_type(2)));
__device__ __forceinline__ unsigned pk2(float lo, float hi) { f32x2 v = {lo, hi}; bf16x2_t b = __builtin_convertvector(v, bf16x2_t); return __builtin_bit_cast(unsigned, b); }
__device__ __forceinline__ float silu_f(float x) { return x * __builtin_amdgcn_rcpf(1.f + __expf(-x)); }
__device__ __forceinline__ float wave_sum(float v) {
#pragma unroll
    for (int o = 1; o < 64; o <<= 1) v += __shfl_xor(v, o);
    return v;
}
__device__ __forceinline__ float wave_max(float v) {
#pragma unroll
    for (int o = 1; o < 64; o <<= 1) v = fmaxf(v, __shfl_xor(v, o));
    return v;
}
__device__ __forceinline__ int t5_bucket(int n) {
    if (n < 16) return n;
    int v = 16 + (int)(logf((float)n * 0.0625f) / 2.0794415416798357f * 16.f);
    return v < 31 ? v : 31;
}

namespace pg8 {
constexpr int BM = 256, BK = 64, HALF = 128, HTB = HALF * BK * 2, STAGE_BYTES = 8 * HTB, NXCD = 8, WGM = 8;
__host__ __device__ __forceinline__ int lds_byte(int r, int c) { const int st = (r >> 4) * 2 + (c >> 5), rr = r & 15, cc = c & 31, ob = rr * 64 + cc * 2; return st * 1024 + (ob ^ (((ob >> 9) & 1) << 5)); }
__host__ __device__ __forceinline__ void stage_rc(int b, int& R, int& C) { const int st = b / 1024, sb = b % 1024, swz = sb ^ (((sb >> 9) & 1) << 5); R = (st >> 1) * 16 + swz / 64; C = (st & 1) * 32 + (swz % 64) / 2; }
__host__ __device__ __forceinline__ int perm32(int rho) { const int n = rho >> 4, i = rho & 15; return 8 * (i >> 2) + 4 * n + (i & 3); }

struct Unit { int pm, pn; };
struct Gemm { const bf16_t* A; const bf16_t* Bt; int M, N, K; };

struct StaticOrder {
    int nM, nN, nwg, G, c;
    __host__ __device__ void init(int M, int N, int G_, int c_) { nM = M / BM; nN = N / BM; nwg = nM * nN; G = G_; c = c_; }
    __host__ __device__ bool next(int i, Unit& u) const {
        const long L = (long)i * G + c; if (L >= nwg) return false;
        int wgid = (int)L; { const int q = nwg / NXCD, r = nwg % NXCD, xcd = wgid % NXCD, off = wgid / NXCD; wgid = (xcd < r ? xcd * (q + 1) : r * (q + 1) + (xcd - r) * q) + off; }
        const int nig = WGM * nN, gid = wgid / nig, fm = gid * WGM, gsz = (nM - fm) < WGM ? (nM - fm) : WGM;
        u.pm = fm + ((wgid % nig) % gsz); u.pn = (wgid % nig) / gsz; return true;
    }
};

template <class Epi>
__device__ __forceinline__ void gemm_phase(LAS unsigned char* lds, const Gemm g, const StaticOrder& S, const Epi& E) {
    const int tid = tid_opaque(), wid = __builtin_amdgcn_readfirstlane(tid >> 6), lane = tid & 63, wr = wid >> 2, wc = wid & 3, fr = lane & 15, fq = lane >> 4;
    const int K = g.K, nt = K / BK;
    unsigned voffA[2], voffB[2];
#pragma unroll
    for (int i = 0; i < 2; ++i) { int R, C; stage_rc(tid * 16 + i * 8192, R, C); const int Rb = (R & ~31) + perm32(R & 31);
        voffA[i] = (unsigned)(R * K + C) * 2u; voffB[i] = (unsigned)(Rb * K + C) * 2u; }
    const size_t kstep = (size_t)(BK * 2);
    const size_t hstep = (size_t)HALF * K * 2;
    const size_t tstep = 2 * hstep;
    const unsigned ldsw = (unsigned)wid * 1024u;
    const int aoff = lds_byte(wr * 64 + fr, fq * 8), boff = lds_byte(wc * 32 + fr, fq * 8);
#define PG8_SA(b, h) (((b) * 2 + (h)) * HTB)
#define PG8_SB(b, h) ((4 + (b) * 2 + (h)) * HTB)
#define PG8_STAGE(bufoff, gbase, voff) do { _Pragma("unroll") for (int _i = 0; _i < 2; ++_i) \
        __builtin_amdgcn_global_load_lds((const unsigned*)((const char*)(gbase) + (voff)[_i]), (LAS unsigned*)(lds + (bufoff) + ldsw + _i * 8192), 16, 0, 0); } while (0)
#define PG8_LDA(dst, b, h) do { _Pragma("unroll") for (int m = 0; m < 4; ++m) _Pragma("unroll") for (int k = 0; k < 2; ++k) dst[m][k] = *(const LAS bf16x8*)(lds + PG8_SA(b, h) + aoff + m * 2048 + k * 1024); } while (0)
#define PG8_LDB(dst, b, h) do { _Pragma("unroll") for (int n = 0; n < 2; ++n) _Pragma("unroll") for (int k = 0; k < 2; ++k) dst[n][k] = *(const LAS bf16x8*)(lds + PG8_SB(b, h) + boff + n * 2048 + k * 1024); } while (0)
#define PG8_MMA(ai, bj, At, Bt) do { __builtin_amdgcn_s_setprio(1); _Pragma("unroll") for (int m = 0; m < 4; ++m) _Pragma("unroll") for (int n = 0; n < 2; ++n) _Pragma("unroll") for (int k = 0; k < 2; ++k) \
        acc[ai][bj][m][n] = __builtin_amdgcn_mfma_f32_16x16x32_bf16(Bt[n][k], At[m][k], acc[ai][bj][m][n], 0, 0, 0); __builtin_amdgcn_s_setprio(0); } while (0)
#define PG8_WAIT_V(n) asm volatile("s_waitcnt vmcnt(" #n ")" ::: "memory")
#define PG8_WAIT_L(n) asm volatile("s_waitcnt lgkmcnt(" #n ")" ::: "memory")
#define PG8_BAR __builtin_amdgcn_s_barrier()
#define PG8_SCHED __builtin_amdgcn_sched_barrier(0)
    Unit cur, nxt; int ui = 0;
    if (!S.next(0, cur)) return;
    f32x4 acc[2][2][4][2];
#pragma unroll
    for (int a = 0; a < 2; ++a)
#pragma unroll
        for (int b = 0; b < 2; ++b)
#pragma unroll
            for (int m = 0; m < 4; ++m)
#pragma unroll
                for (int n = 0; n < 2; ++n) acc[a][b][m][n] = (f32x4){0.f, 0.f, 0.f, 0.f};
    bf16x8 At[4][2], B0[2][2], B1[2][2];
    const char* cA = (const char*)g.A + (size_t)cur.pm * tstep; const char* cB = (const char*)g.Bt + (size_t)cur.pn * tstep;
    PG8_STAGE(PG8_SB(0, 0), cB, voffB); PG8_STAGE(PG8_SB(0, 1), cB + hstep, voffB); PG8_STAGE(PG8_SA(0, 0), cA, voffA); PG8_STAGE(PG8_SA(0, 1), cA + hstep, voffA);
    if (wr == 1) PG8_BAR;
    PG8_WAIT_V(2); PG8_BAR;
    PG8_STAGE(PG8_SB(1, 0), cB + kstep, voffB); PG8_STAGE(PG8_SA(1, 0), cA + kstep, voffA); PG8_STAGE(PG8_SB(1, 1), cB + hstep + kstep, voffB);
    PG8_WAIT_V(6); PG8_BAR;
    for (;;) {
        const bool has_next = S.next(ui + 1, nxt);
        const char* nA = has_next ? (const char*)g.A + (size_t)nxt.pm * tstep : cA; const char* nB = has_next ? (const char*)g.Bt + (size_t)nxt.pn * tstep : cB;
        for (int t = 0; t < nt; t += 2) {
            const bool last = (t == nt - 2);
            const char* a1 = cA + (size_t)(t + 1) * kstep;
            const char* a2 = last ? nA : cA + (size_t)(t + 2) * kstep; const char* b2 = last ? nB : cB + (size_t)(t + 2) * kstep;
            const char* a3 = a2 + kstep; const char* b3 = b2 + kstep;
            PG8_LDB(B0, 0, 0); PG8_LDB(B1, 0, 1); PG8_SCHED; PG8_LDA(At, 0, 0); PG8_STAGE(PG8_SA(1, 1), a1 + hstep, voffA);
            PG8_WAIT_V(8); PG8_WAIT_L(0); PG8_BAR; PG8_MMA(0, 0, At, B0); PG8_MMA(0, 1, At, B1); PG8_BAR; PG8_SCHED;
            PG8_LDA(At, 0, 1); PG8_STAGE(PG8_SB(0, 0), b2, voffB); PG8_STAGE(PG8_SB(0, 1), b2 + hstep, voffB); PG8_STAGE(PG8_SA(0, 0), a2, voffA);
            PG8_WAIT_V(8); PG8_WAIT_L(0); PG8_BAR; PG8_MMA(1, 0, At, B0); PG8_MMA(1, 1, At, B1); PG8_BAR; PG8_SCHED;
            PG8_LDB(B0, 1, 0); PG8_LDB(B1, 1, 1); PG8_SCHED; PG8_LDA(At, 1, 0); PG8_STAGE(PG8_SA(0, 1), a2 + hstep, voffA);
            PG8_WAIT_V(8); PG8_WAIT_L(0); PG8_BAR; PG8_MMA(0, 0, At, B0); PG8_MMA(0, 1, At, B1); PG8_BAR; PG8_SCHED;
            PG8_LDA(At, 1, 1); PG8_STAGE(PG8_SB(1, 0), b3, voffB); PG8_STAGE(PG8_SB(1, 1), b3 + hstep, voffB); PG8_STAGE(PG8_SA(1, 0), a3, voffA);
            PG8_WAIT_V(8); PG8_WAIT_L(0); PG8_BAR; PG8_MMA(1, 0, At, B0); PG8_MMA(1, 1, At, B1); PG8_BAR; PG8_SCHED;
        }
        if (wr == 0) PG8_BAR;
        E(acc, cur, wr, wc, fr, fq);
        if (!has_next) break;
#pragma unroll
        for (int a = 0; a < 2; ++a)
#pragma unroll
            for (int b = 0; b < 2; ++b)
#pragma unroll
                for (int m = 0; m < 4; ++m)
#pragma unroll
                    for (int n = 0; n < 2; ++n) acc[a][b][m][n] = (f32x4){0.f, 0.f, 0.f, 0.f};
        cur = nxt; cA = nA; cB = nB; ++ui;
        if (wr == 1) PG8_BAR;
    }
    PG8_WAIT_V(0);
    PG8_BAR;
#undef PG8_SA
#undef PG8_SB
#undef PG8_STAGE
#undef PG8_LDA
#undef PG8_LDB
#undef PG8_MMA
#undef PG8_WAIT_V
#undef PG8_WAIT_L
#undef PG8_BAR
#undef PG8_SCHED
}
}

struct EpiIn {
    bf16_t* U; float* LF; const unsigned long long* ssq; const float* lb;
    template <int MODE>
    __device__ __forceinline__ void body(const f32x4 (&acc)[2][2][4][2], const pg8::Unit& u, int wr, int wc, int fr, int fq) const {
        const int row0 = u.pm * 256 + wr * 64 + fr, colb = u.pn * 256 + wc * 32 + 8 * fq;
#pragma unroll
        for (int bj = 0; bj < 2; ++bj) {
            const int col = colb + bj * 128;
            f32x4 l0 = (f32x4){0.f, 0.f, 0.f, 0.f}, l1 = l0;
            if (MODE == 1) { l0 = *(const f32x4*)(lb + col - 1024); l1 = *(const f32x4*)(lb + col - 1020); }
#pragma unroll
            for (int ai = 0; ai < 2; ++ai)
#pragma unroll
                for (int m = 0; m < 4; ++m) {
                    const int row = row0 + ai * 128 + m * 16;
                    const float rstd = rsqrtf((float)ssq[row] * (SSQ_INV / DM) + EPS);
                    float v[8];
#pragma unroll
                    for (int e = 0; e < 8; ++e) v[e] = acc[ai][bj][m][e >> 2][e & 3] * rstd;
                    if (MODE == 0) {
#pragma unroll
                        for (int e = 0; e < 8; ++e) v[e] = silu_f(v[e]);
                    } else if (MODE == 1) {
                        float lf[8];
#pragma unroll
                        for (int e = 0; e < 8; ++e) {
                            const float z = v[e], l = (e < 4) ? l0[e & 3] : l1[e & 3];
                            const float ez = __expf(-fabsf(z));
                            const float inv = __builtin_amdgcn_rcpf(1.f + ez);
                            const float big = inv, small = ez * inv;
                            const float sp = (z >= 0.f) ? big : small;
                            const float sn = (z >= 0.f) ? small : big;
                            const float lsig = fminf(z, 0.f) - __logf(1.f + ez);
                            lf[e] = (l > 0.f) ? __logf(l + (1.f - l) * sp) : lsig;
                            v[e] = (1.f - l) * sn;
                        }
                        float* lp = LF + (size_t)row * 1024 + (col - 1024);
                        *(f32x4*)lp = (f32x4){lf[0], lf[1], lf[2], lf[3]}; *(f32x4*)(lp + 4) = (f32x4){lf[4], lf[5], lf[6], lf[7]};
                    }
                    u32x4 w; w.x = pk2(v[0], v[1]); w.y = pk2(v[2], v[3]); w.z = pk2(v[4], v[5]); w.w = pk2(v[6], v[7]);
                    *(u32x4*)(U + (size_t)row * INW + col) = w;
                }
        }
    }
    __device__ __forceinline__ void operator()(const f32x4 (&acc)[2][2][4][2], const pg8::Unit& u, int wr, int wc, int fr, int fq) const {
        const int seg = u.pn >> 2;
        if (seg == 0 || seg == 3) body<0>(acc, u, wr, wc, fr, fq);
        else if (seg == 1) body<1>(acc, u, wr, wc, fr, fq);
        else body<2>(acc, u, wr, wc, fr, fq);
    }
};
struct EpiRes {
    bf16_t* XB; unsigned long long* ssq; float* outp;
    __device__ __forceinline__ void operator()(const f32x4 (&acc)[2][2][4][2], const pg8::Unit& u, int wr, int wc, int fr, int fq) const {
        const int row0 = u.pm * 256 + wr * 64 + fr, colb = u.pn * 256 + wc * 32 + 8 * fq;
#pragma unroll
        for (int ai = 0; ai < 2; ++ai)
#pragma unroll
            for (int m = 0; m < 4; ++m) {
                const int row = row0 + ai * 128 + m * 16;
                float s = 0.f;
#pragma unroll
                for (int bj = 0; bj < 2; ++bj) {
                    const int col = colb + bj * 128;
                    bf16_t* xp = XB + (size_t)row * DM + col;
                    const u32x4 w0 = *(const u32x4*)xp;
                    const f32x4 x0 = (f32x4){bf2f(w0.x & 0xffffu), bf2f(w0.x >> 16), bf2f(w0.y & 0xffffu), bf2f(w0.y >> 16)} + acc[ai][bj][m][0];
                    const f32x4 x1 = (f32x4){bf2f(w0.z & 0xffffu), bf2f(w0.z >> 16), bf2f(w0.w & 0xffffu), bf2f(w0.w >> 16)} + acc[ai][bj][m][1];
                    if (outp) {
                        if (row < MR) { float* op = outp + (size_t)row * DM + col; *(f32x4*)op = x0; *(f32x4*)(op + 4) = x1; }
                    } else {
                        u32x4 w; w.x = pk2(x0[0], x0[1]); w.y = pk2(x0[2], x0[3]); w.z = pk2(x1[0], x1[1]); w.w = pk2(x1[2], x1[3]);
                        *(u32x4*)xp = w;
                        s += (x0[0] * x0[0] + x0[1] * x0[1]) + (x0[2] * x0[2] + x0[3] * x0[3]) + (x1[0] * x1[0] + x1[1] * x1[1]) + (x1[2] * x1[2] + x1[3] * x1[3]);
                    }
                }
                if (!outp) {
                    s += __shfl_xor(s, 16); s += __shfl_xor(s, 32);
                    if (fq == 0) atomicAdd(ssq + row, (unsigned long long)(s * SSQ_SCALE));
                }
            }
    }
};
struct EpiGU {
    bf16_t* ACT; const unsigned long long* ssq;
    __device__ __forceinline__ void operator()(const f32x4 (&acc)[2][2][4][2], const pg8::Unit& u, int wr, int wc, int fr, int fq) const {
        const int row0 = u.pm * 256 + wr * 64 + fr, col = u.pn * 128 + wc * 32 + 8 * fq;
#pragma unroll
        for (int ai = 0; ai < 2; ++ai)
#pragma unroll
            for (int m = 0; m < 4; ++m) {
                const int row = row0 + ai * 128 + m * 16;
                const float rstd = rsqrtf((float)ssq[row] * (SSQ_INV / DM) + EPS);
                float v[8];
#pragma unroll
                for (int e = 0; e < 8; ++e) v[e] = silu_f(acc[ai][0][m][e >> 2][e & 3] * rstd) * (acc[ai][1][m][e >> 2][e & 3] * rstd);
                u32x4 w; w.x = pk2(v[0], v[1]); w.y = pk2(v[2], v[3]); w.z = pk2(v[4], v[5]); w.w = pk2(v[6], v[7]);
                *(u32x4*)(ACT + (size_t)row * FFW + col) = w;
            }
    }
};

struct EpiNull {
    float* sink;
    __device__ __forceinline__ void operator()(const f32x4 (&acc)[2][2][4][2], const pg8::Unit& u, int wr, int wc, int fr, int fq) const {
        float t = 0.f;
#pragma unroll
        for (int ai = 0; ai < 2; ++ai)
#pragma unroll
            for (int bj = 0; bj < 2; ++bj)
#pragma unroll
                for (int m = 0; m < 4; ++m)
#pragma unroll
                    for (int n = 0; n < 2; ++n) t += acc[ai][bj][m][n][0] + acc[ai][bj][m][n][1] + acc[ai][bj][m][n][2] + acc[ai][bj][m][n][3];
        if (t == 1.2345e30f) sink[0] = t;
    }
};
struct CvtItem { const float* W; const float* g; bf16_t* WT; int K, N, k0, n0, r0; };
__device__ __forceinline__ void cvt_decode(const Params& p, int l, int it, CvtItem& c) {
    constexpr int I_IN = 32 * 176, I_OUT = 32 * 64, I_G = 32 * 176;
    unsigned char* wl = p.ws + WS_W + (size_t)l * W_LAYER;
    int r = it, gu = 0, up = 0;
    if (r < I_IN) { c.W = p.w_in + (size_t)l * DM * INW; c.g = p.norm_mix + l * DM; c.WT = (bf16_t*)(wl + W_IN_OFF); c.K = DM; c.N = INW; }
    else if ((r -= I_IN) < I_OUT) { c.W = p.w_out + (size_t)l * DM * DM; c.g = nullptr; c.WT = (bf16_t*)(wl + W_OUT_OFF); c.K = DM; c.N = DM; }
    else if ((r -= I_OUT) < I_G) { c.W = p.w_gate + (size_t)l * DM * FFW; c.g = p.norm_ffn + l * DM; c.WT = (bf16_t*)(wl + W_GU_OFF); c.K = DM; c.N = FFW; gu = 1; }
    else if ((r -= I_G) < I_G) { c.W = p.w_up + (size_t)l * DM * FFW; c.g = p.norm_ffn + l * DM; c.WT = (bf16_t*)(wl + W_GU_OFF); c.K = DM; c.N = FFW; gu = 1; up = 1; }
    else { r -= I_G; c.W = p.w_down + (size_t)l * FFW * DM; c.g = nullptr; c.WT = (bf16_t*)(wl + W_DN_OFF); c.K = FFW; c.N = DM; }
    const int nblk = c.N / 32, kb = r / nblk, nb = r % nblk;
    c.k0 = 64 * kb; c.n0 = 32 * nb;
    c.r0 = gu ? ((c.n0 >> 7) * 256 + (c.n0 & 127) + (up ? 128 : 0)) : c.n0;
}
__device__ __forceinline__ void cvt_load(const CvtItem& c, int lane, float (&wv)[32], f32x4 (&gl)[2]) {
    if (c.g) { gl[0] = *(const f32x4*)(c.g + c.k0 + 8 * (lane & 7)); gl[1] = *(const f32x4*)(c.g + c.k0 + 8 * (lane & 7) + 4); }
    else { gl[0] = (f32x4){1.f, 1.f, 1.f, 1.f}; gl[1] = gl[0]; }
#pragma unroll
    for (int i = 0; i < 32; ++i) wv[i] = __builtin_nontemporal_load(&c.W[(size_t)(c.k0 + 2 * i + (lane >> 5)) * c.N + c.n0 + (lane & 31)]);
}
__device__ __forceinline__ void cvt_store(const CvtItem& c, int lane, const float (&wv)[32], const f32x4 (&gl)[2], LAS float* scr) {
#pragma unroll
    for (int i = 0; i < 32; ++i) { const int kk = 2 * i + (lane >> 5); scr[kk * 33 + (lane & 31)] = wv[i]; }
    asm volatile("s_waitcnt lgkmcnt(0)" ::: "memory");
    const int cc = lane & 7;
#pragma unroll
    for (int j = 0; j < 4; ++j) { const int n = (lane >> 3) + 8 * j; const LAS float* sp = scr + (8 * cc) * 33 + n;
        u32x4 o; o.x = pk2(sp[0 * 33] * gl[0][0], sp[1 * 33] * gl[0][1]); o.y = pk2(sp[2 * 33] * gl[0][2], sp[3 * 33] * gl[0][3]);
        o.z = pk2(sp[4 * 33] * gl[1][0], sp[5 * 33] * gl[1][1]); o.w = pk2(sp[6 * 33] * gl[1][2], sp[7 * 33] * gl[1][3]);
        *(u32x4*)(c.WT + (size_t)(c.r0 + n) * c.K + c.k0 + 8 * cc) = o; }
    asm volatile("s_waitcnt lgkmcnt(0)" ::: "memory");
}
__device__ __forceinline__ void convert_weights(const Params& p, LAS unsigned char* lds, int l, int gw, int NGW, int it_lo, int it_hi) {
    const int tid = tid_opaque(), lane = tid & 63, wave = tid >> 6;
    LAS float* scr = (LAS float*)(lds + wave * 16384);
    constexpr int I_L = 32 * 176 * 3 + 32 * 64 + 88 * 64;
    asm volatile("" : "+s"(gw), "+s"(NGW));
    (void)I_L;
    if (it_lo + gw >= it_hi) return;
    CvtItem cur, nxt; float wv[32], wn[32]; f32x4 gl[2], gn_[2];
    cvt_decode(p, l, it_lo + gw, cur); cvt_load(cur, lane, wv, gl);
    for (int it = it_lo + gw; it < it_hi; it += NGW) {
        const bool more = it + NGW < it_hi;
        if (more) { cvt_decode(p, l, it + NGW, nxt); cvt_load(nxt, lane, wn, gn_); }
        cvt_store(cur, lane, wv, gl, scr);
        if (more) { cur = nxt; gl[0] = gn_[0]; gl[1] = gn_[1];
#pragma unroll
            for (int i = 0; i < 32; ++i) wv[i] = wn[i]; }
    }
}

__device__ __forceinline__ void prologue(const Params& p, LAS unsigned char* lds) {
    const int tid = tid_opaque(), lane = tid & 63, wave = tid >> 6, G = gridDim.x;
    const int gw = blockIdx.x * 8 + wave, NGW = G * 8;
    const int gt = blockIdx.x * 512 + tid, NGT = G * 512;
    unsigned char* ws = p.ws;
    if (gt < 1024) {
        float v[4], mx = -3.4e38f;
        for (int l = 0; l < 4; ++l) { v[l] = p.lower_bounds[l * 1024 + gt]; mx = fmaxf(mx, v[l]); }
        float s = 0.f; for (int l = 0; l < 4; ++l) { v[l] = expf(v[l] - mx); s += v[l]; }
        float* lb = (float*)(ws + WS_LB); float cum = 0.f;
        for (int l = 0; l < 4; ++l) { const float pl = v[l] / s; cum += pl; lb[l * 1024 + gt] = (l == 0) ? 0.f : cum - v[0] / s; }
    }
    { unsigned long long* ssq = (unsigned long long*)(ws + WS_SSQ); for (int i = gt; i < 8 * MP; i += NGT) ssq[MP + i] = 0ull; }
    {
        float* X = (float*)(ws + WS_X); bf16_t* XB = (bf16_t*)(ws + WS_XB); unsigned long long* ssq = (unsigned long long*)(ws + WS_SSQ); bf16_t* MIX = (bf16_t*)(ws + WS_MIX);
        for (int r = gw; r < MP; r += NGW) {
            const float* src = r < NPROMPT ? p.x_prompt + (size_t)r * DM : (r < MR ? p.x_sample + (size_t)(r - NPROMPT) * DM : nullptr);
            float s = 0.f;
#pragma unroll
            for (int j = 0; j < 8; ++j) {
                const int cidx = (j * 64 + lane) * 4;
                f32x4 v = src ? *(const f32x4*)(src + cidx) : (f32x4){0.f, 0.f, 0.f, 0.f};
                u32x2 w; w.x = pk2(v[0], v[1]); w.y = pk2(v[2], v[3]);
                *(u32x2*)(XB + (size_t)r * DM + cidx) = w;
                s += (v[0] * v[0] + v[1] * v[1]) + (v[2] * v[2] + v[3] * v[3]);
                if (r >= MR) *(u32x2*)(MIX + (size_t)r * DM + cidx) = (u32x2){0u, 0u};
            }
            s = wave_sum(s);
            if (lane == 0) ssq[r] = (unsigned long long)(s * SSQ_SCALE);
        }
    }
    convert_weights(p, lds, 0, __builtin_amdgcn_readfirstlane(gw), NGW, 0, CVT_SPLIT);
}

#define LBAR() asm volatile("s_waitcnt lgkmcnt(0)\n\ts_barrier" ::: "memory")
#define MFMA16(a, b, c) __builtin_amdgcn_mfma_f32_16x16x32_bf16((a), (b), (c), 0, 0, 0)
__device__ __forceinline__ bf16x8 mk8(unsigned a, unsigned b, unsigned c, unsigned d) { u32x4 w = (u32x4){a, b, c, d}; return __builtin_bit_cast(bf16x8, w); }
__device__ __forceinline__ bf16x8 ld8x2(const LAS bf16_t* p0, const LAS bf16_t* p1) { u32x2 a = *(const LAS u32x2*)p0, b = *(const LAS u32x2*)p1; return mk8(a.x, a.y, b.x, b.y); }

constexpr size_t PREP_ITEM_BYTES = 90112, PREP_S_OFF = 49152;
__device__ __forceinline__ void prep_item(const Params& p, int l, int it, LAS unsigned char* lds) {
    const int tid = tid_opaque(), lane = tid & 63, wid = __builtin_amdgcn_readfirstlane(tid >> 6), l15 = lane & 15, quad = lane >> 4;
    const int c = tid & 127, tq = tid >> 7;
    const int n = it & 31, h = (it >> 5) & 7, b = it >> 8;
    LAS bf16_t* QT = (LAS bf16_t*)(lds + 0); LAS bf16_t* KT = (LAS bf16_t*)(lds + 17408); LAS bf16_t* QH = (LAS bf16_t*)(lds + 34816);
    LAS bf16_t* KHt = (LAS bf16_t*)(lds + 52224); LAS bf16_t* Vt = (LAS bf16_t*)(lds + 70656);
    LAS float* TOT = (LAS float*)(lds + 123904); LAS float* DEC = (LAS float*)(lds + 125952);
    const bf16_t* U = (const bf16_t*)(p.ws + WS_U); const float* LF = (const float*)(p.ws + WS_LF);
    unsigned char* sb = p.ws + WS_ACT + (size_t)it * PREP_ITEM_BYTES;
    float lf[16]; unsigned short qr[16], kr[16], vr[16];
    {
        const size_t r0 = (size_t)b * SEQ + n * 64 + tq * 16;
#pragma unroll
        for (int i = 0; i < 16; ++i) { lf[i] = __builtin_nontemporal_load(&LF[(r0 + i) * 1024 + h * 128 + c]); const bf16_t* up = U + (r0 + i) * INW + h * 128 + c; qr[i] = __builtin_nontemporal_load(up); kr[i] = __builtin_nontemporal_load(up + 1024); vr[i] = __builtin_nontemporal_load(up + 2048); }
    }
    float cs[16]; float run = 0.f;
#pragma unroll
    for (int i = 0; i < 16; ++i) { run += lf[i]; cs[i] = run; }
    TOT[tq * 128 + c] = run;
    {
        u32x4 w0, w1;
        w0.x = (unsigned)vr[0] | ((unsigned)vr[1] << 16); w0.y = (unsigned)vr[2] | ((unsigned)vr[3] << 16); w0.z = (unsigned)vr[4] | ((unsigned)vr[5] << 16); w0.w = (unsigned)vr[6] | ((unsigned)vr[7] << 16);
        w1.x = (unsigned)vr[8] | ((unsigned)vr[9] << 16); w1.y = (unsigned)vr[10] | ((unsigned)vr[11] << 16); w1.z = (unsigned)vr[12] | ((unsigned)vr[13] << 16); w1.w = (unsigned)vr[14] | ((unsigned)vr[15] << 16);
        *(LAS u32x4*)(Vt + c * 72 + tq * 16) = w0; *(LAS u32x4*)(Vt + c * 72 + tq * 16 + 8) = w1;
    }
    LBAR();
    {
        float pre = 0.f;
        const float t0 = TOT[c], t1 = TOT[128 + c], t2 = TOT[256 + c], t3 = TOT[384 + c];
        if (tq >= 1) pre += t0; if (tq >= 2) pre += t1; if (tq >= 3) pre += t2;
        const float bmid = t0 + t1, blast = (t0 + t1) + (t2 + t3);
        unsigned kh[8];
#pragma unroll
        for (int i = 0; i < 16; i += 2) {
            const float b0 = pre + cs[i], b1 = pre + cs[i + 1];
            const float q0 = bf2f(qr[i]), q1 = bf2f(qr[i + 1]), k0 = bf2f(kr[i]), k1 = bf2f(kr[i + 1]);
            const int tt = tq * 16 + i;
            QT[tt * 136 + c] = (bf16_t)(pk2(q0 * __expf(b0 - bmid), 0.f) & 0xffffu);       QT[(tt + 1) * 136 + c] = (bf16_t)(pk2(q1 * __expf(b1 - bmid), 0.f) & 0xffffu);
            KT[tt * 136 + c] = (bf16_t)(pk2(k0 * __expf(bmid - b0), 0.f) & 0xffffu);       KT[(tt + 1) * 136 + c] = (bf16_t)(pk2(k1 * __expf(bmid - b1), 0.f) & 0xffffu);
            QH[tt * 136 + c] = (bf16_t)(pk2(q0 * __expf(b0), 0.f) & 0xffffu);              QH[(tt + 1) * 136 + c] = (bf16_t)(pk2(q1 * __expf(b1), 0.f) & 0xffffu);
            kh[i >> 1] = pk2(k0 * __expf(blast - b0), k1 * __expf(blast - b1));
        }
        *(LAS u32x4*)(KHt + c * 72 + tq * 16) = (u32x4){kh[0], kh[1], kh[2], kh[3]}; *(LAS u32x4*)(KHt + c * 72 + tq * 16 + 8) = (u32x4){kh[4], kh[5], kh[6], kh[7]};
        if (tq == 0) DEC[c] = __expf(blast);
    }
    LBAR();
    {
        const int mt = wid & 3, dh = wid >> 2;
        f32x4 aa[4];
#pragma unroll
        for (int st = 0; st < 4; ++st) aa[st] = (f32x4){0.f, 0.f, 0.f, 0.f};
        bf16x8 qfr[4];
#pragma unroll
        for (int kk = 0; kk < 4; ++kk) qfr[kk] = *(const LAS bf16x8*)(QT + (16 * mt + l15) * 136 + 32 * kk + 8 * quad);
#pragma unroll
        for (int st = 0; st < 4; ++st) if (st <= mt) {
#pragma unroll
            for (int kk = 0; kk < 4; ++kk) aa[st] = MFMA16(*(const LAS bf16x8*)(KT + (16 * st + l15) * 136 + 32 * kk + 8 * quad), qfr[kk], aa[st]);
            if (st == mt) {
#pragma unroll
                for (int j = 0; j < 4; ++j) if (4 * quad + j > l15) aa[st][j] = 0.f;
            }
        }
        bf16x8 pf[2];
        pf[0] = mk8(pk2(aa[0][0], aa[0][1]), pk2(aa[0][2], aa[0][3]), pk2(aa[1][0], aa[1][1]), pk2(aa[1][2], aa[1][3]));
        pf[1] = mk8(pk2(aa[2][0], aa[2][1]), pk2(aa[2][2], aa[2][3]), pk2(aa[3][0], aa[3][1]), pk2(aa[3][2], aa[3][3]));
        u32x2* OI = (u32x2*)sb;
#pragma unroll
        for (int n4 = 0; n4 < 4; ++n4) {
            const int nt = dh * 4 + n4;
            f32x4 o = (f32x4){0.f, 0.f, 0.f, 0.f};
            const LAS bf16_t* vrow = Vt + (16 * nt + l15) * 72 + 4 * quad;
            o = MFMA16(ld8x2(vrow, vrow + 16), pf[0], o);
            if (mt >= 2) o = MFMA16(ld8x2(vrow + 32, vrow + 48), pf[1], o);
            OI[(mt * 8 + nt) * 64 + lane] = (u32x2){pk2(o[0], o[1]), pk2(o[2], o[3])};
        }
        bf16x8* QHF = (bf16x8*)(sb + 32768);
        if (dh == 0) {
#pragma unroll
            for (int kk = 0; kk < 4; ++kk) QHF[(mt * 4 + kk) * 64 + lane] = *(const LAS bf16x8*)(QH + (16 * mt + l15) * 136 + 32 * kk + 8 * quad);
        }
        bf16x8* KHF = (bf16x8*)(sb + PREP_S_OFF); bf16x8* VF = (bf16x8*)(sb + PREP_S_OFF + 16384); float* DCG = (float*)(sb + PREP_S_OFF + 32768);
#pragma unroll
        for (int ks = 0; ks < 2; ++ks) {
            KHF[(wid * 2 + ks) * 64 + lane] = *(const LAS bf16x8*)(KHt + (16 * wid + l15) * 72 + 32 * ks + 8 * quad);
            VF[(wid * 2 + ks) * 64 + lane] = *(const LAS bf16x8*)(Vt + (16 * wid + l15) * 72 + 32 * ks + 8 * quad);
        }
        if (tid < 128) DCG[tid] = DEC[tid];
    }
    LBAR();
}

__device__ __forceinline__ void scan2_item(const Params& p, int l, int b, int h, LAS unsigned char* lds) {
    const int tid = tid_opaque(), lane = tid & 63, wid = __builtin_amdgcn_readfirstlane(tid >> 6), l15 = lane & 15, quad = lane >> 4;
    LAS bf16_t* St = (LAS bf16_t*)(lds + 98304); LAS float* GNL = (LAS float*)(lds + 133120); LAS float* SSX = (LAS float*)(lds + 133632); LAS float* DECL = (LAS float*)(lds + 134144);
    const bf16_t* U = (const bf16_t*)(p.ws + WS_U); bf16_t* MIX = (bf16_t*)(p.ws + WS_MIX);
    const unsigned char* sb0 = p.ws + WS_ACT + (size_t)((b * 8 + h) * 32) * PREP_ITEM_BYTES;
    if (tid < 128) GNL[tid] = p.hgrn_norm[l * 128 + tid];
    for (int i = tid; i < 34816 / 4; i += 512) ((LAS unsigned*)St)[i] = 0u;
    f32x4 sacc[8];
#pragma unroll
    for (int a = 0; a < 8; ++a) sacc[a] = (f32x4){0.f, 0.f, 0.f, 0.f};
    const int mt = wid & 3, dh = wid >> 2;
#define S2_DMA(n_) do { const unsigned char* g_ = sb0 + (size_t)(n_) * PREP_ITEM_BYTES + PREP_S_OFF; const unsigned sl_ = (unsigned)((n_) % 3); \
        _Pragma("unroll") for (int f = 0; f < 4; ++f) __builtin_amdgcn_global_load_lds((const unsigned*)(g_ + ((wid * 4 + f) * 64 + lane) * 16), (LAS unsigned*)(lds + sl_ * 32768u + (wid * 4 + f) * 1024), 16, 0, 0); \
        __builtin_amdgcn_global_load_lds((const unsigned*)(g_ + 32768 + lane * 16), (LAS unsigned*)(lds + 134144 + sl_ * 1024u), 16, 0, 0); } while (0)
#define S2_OLOAD(n_, OI_, QF_, GW_) do { const unsigned char* g_ = sb0 + (size_t)(n_) * PREP_ITEM_BYTES; \
        _Pragma("unroll") for (int n4 = 0; n4 < 4; ++n4) OI_[n4] = ((const u32x2*)g_)[(mt * 8 + dh * 4 + n4) * 64 + lane]; \
        _Pragma("unroll") for (int kk = 0; kk < 4; ++kk) QF_[kk] = ((const bf16x8*)(g_ + 32768))[(mt * 4 + kk) * 64 + lane]; \
        const size_t rw_ = (size_t)b * SEQ + (n_) * 64 + 16 * mt + l15; \
        _Pragma("unroll") for (int n4 = 0; n4 < 4; ++n4) GW_[n4] = *(const u32x2*)(U + rw_ * INW + 3072 + h * 128 + 16 * (dh * 4 + n4) + 4 * quad); } while (0)
    u32x2 oiX[4], oiY[4], oiA[4]; bf16x8 qfX[4], qfY[4], qfA[4]; u32x2 gwX[4], gwY[4], gwA[4];
    S2_DMA(0); S2_DMA(1); S2_OLOAD(0, oiX, qfX, gwX); S2_OLOAD(1, oiY, qfY, gwY);
    asm volatile("s_waitcnt vmcnt(0)" ::: "memory");
    LBAR();
#define S2_BODY(n_, OIT, QFT, GWT) do { \
        _Pragma("unroll") for (int n4 = 0; n4 < 4; ++n4) { oiA[n4] = OIT[n4]; gwA[n4] = GWT[n4]; } \
        _Pragma("unroll") for (int kk = 0; kk < 4; ++kk) qfA[kk] = QFT[kk]; \
        if ((n_) + 2 < 32) { S2_DMA((n_) + 2); S2_OLOAD((n_) + 2, OIT, QFT, GWT); } \
        const int slot_ = (n_) % 3; \
        f32x4 oo[4]; float ss = 0.f; \
        _Pragma("unroll") for (int h2 = 0; h2 < 2; ++h2) { \
            bf16x8 sf[2][4]; \
            _Pragma("unroll") for (int t2 = 0; t2 < 2; ++t2) _Pragma("unroll") for (int kk = 0; kk < 4; ++kk) sf[t2][kk] = *(const LAS bf16x8*)(St + (16 * (dh * 4 + 2 * h2 + t2) + l15) * 136 + 32 * kk + 8 * quad); \
            __builtin_amdgcn_sched_barrier(0); \
            _Pragma("unroll") for (int t2 = 0; t2 < 2; ++t2) { \
                const u32x2 ow = oiA[2 * h2 + t2]; \
                f32x4 o = (f32x4){bf2f(ow.x & 0xffffu), bf2f(ow.x >> 16), bf2f(ow.y & 0xffffu), bf2f(ow.y >> 16)}; \
                _Pragma("unroll") for (int kk = 0; kk < 4; ++kk) o = MFMA16(sf[t2][kk], qfA[kk], o); \
                oo[2 * h2 + t2] = o; ss += (o[0] * o[0] + o[1] * o[1]) + (o[2] * o[2] + o[3] * o[3]); } } \
        ss += __shfl_xor(ss, 16); ss += __shfl_xor(ss, 32); \
        if (quad == 0) SSX[dh * 64 + 16 * mt + l15] = ss; \
        { const LAS unsigned char* sbuf = lds + slot_ * 32768; const LAS float* dcl = DECL + slot_ * 256; \
          const bf16x8 vf0 = *(const LAS bf16x8*)(sbuf + 16384 + ((wid * 2 + 0) * 64 + lane) * 16), vf1 = *(const LAS bf16x8*)(sbuf + 16384 + ((wid * 2 + 1) * 64 + lane) * 16); \
          _Pragma("unroll") for (int h2 = 0; h2 < 2; ++h2) { \
              f32x4 dc[4]; bf16x8 kf0[4], kf1[4]; \
              _Pragma("unroll") for (int d4 = 0; d4 < 4; ++d4) { const int dkt = 4 * h2 + d4; dc[d4] = *(const LAS f32x4*)(dcl + 16 * dkt + 4 * quad); \
                  kf0[d4] = *(const LAS bf16x8*)(sbuf + ((dkt * 2 + 0) * 64 + lane) * 16); kf1[d4] = *(const LAS bf16x8*)(sbuf + ((dkt * 2 + 1) * 64 + lane) * 16); } \
              __builtin_amdgcn_sched_barrier(0); \
              _Pragma("unroll") for (int d4 = 0; d4 < 4; ++d4) { const int dkt = 4 * h2 + d4; f32x4 sv = sacc[dkt] * dc[d4]; sv = MFMA16(kf0[d4], vf0, sv); sv = MFMA16(kf1[d4], vf1, sv); sacc[dkt] = sv; } } } \
        LBAR(); \
        _Pragma("unroll") for (int dkt = 0; dkt < 8; ++dkt) { const f32x4 sv = sacc[dkt]; \
            *(LAS u32x2*)(St + (16 * wid + l15) * 136 + 16 * dkt + 4 * quad) = (u32x2){pk2(sv[0], sv[1]), pk2(sv[2], sv[3])}; } \
        { const float sst = SSX[16 * mt + l15] + SSX[64 + 16 * mt + l15]; const float rstd = rsqrtf(sst * (1.f / 128.f) + EPS); \
          const size_t r = (size_t)b * SEQ + (n_) * 64 + 16 * mt + l15; \
          _Pragma("unroll") for (int n4 = 0; n4 < 4; ++n4) { const int dv0 = 16 * (dh * 4 + n4) + 4 * quad; const u32x2 gw = gwA[n4]; const f32x4 gv = *(const LAS f32x4*)(GNL + dv0); \
              const float o0 = oo[n4][0] * rstd * gv[0] * bf2f(gw.x & 0xffffu), o1 = oo[n4][1] * rstd * gv[1] * bf2f(gw.x >> 16); \
              const float o2 = oo[n4][2] * rstd * gv[2] * bf2f(gw.y & 0xffffu), o3 = oo[n4][3] * rstd * gv[3] * bf2f(gw.y >> 16); \
              *(u32x2*)(MIX + r * DM + h * 128 + dv0) = (u32x2){pk2(o0, o1), pk2(o2, o3)}; } } \
          \
        if ((n_) + 2 < 32) asm volatile("s_waitcnt vmcnt(25)" ::: "memory"); else asm volatile("s_waitcnt vmcnt(4)" ::: "memory"); \
        LBAR(); } while (0)
    for (int n = 0; n < 32; n += 2) {
        S2_BODY(n, oiX, qfX, gwX);
        S2_BODY(n + 1, oiY, qfY, gwY);
    }
#undef S2_BODY
#undef S2_DMA
#undef S2_OLOAD
    {
        float* ps = p.out + O_PS + ((size_t)(l * 4 + b) * 8 + h) * 16384;
#pragma unroll
        for (int dkt = 0; dkt < 8; ++dkt)
#pragma unroll
            for (int j = 0; j < 4; ++j) ps[(16 * dkt + 4 * quad + j) * 128 + 16 * wid + l15] = sacc[dkt][j];
    }
    __syncthreads();
}

__device__ __forceinline__ void attn_item(const Params& p, int l, int b, int blk, int hk, LAS unsigned char* lds) {
    const int tid = tid_opaque(), lane = tid & 63, wid = __builtin_amdgcn_readfirstlane(tid >> 6), l15 = lane & 15, quad = lane >> 4;
    LAS bf16_t* Kn = (LAS bf16_t*)(lds + 0); LAS bf16_t* Vt = (LAS bf16_t*)(lds + 36864); LAS float* BT = (LAS float*)(lds + 70656);
    const bf16_t* U = (const bf16_t*)(p.ws + WS_U); bf16_t* MIX = (bf16_t*)(p.ws + WS_MIX);
    {
        const int j = tid >> 1, half = tid & 1;
        const bool live = (blk > 0) || (j >= 128);
        const size_t r = (size_t)b * SEQ + blk * 128 - 128 + j;
        float kv[32]; unsigned vw[16];
        if (live) {
            const bf16_t* kp = U + r * INW + 5120 + hk * 64 + half * 32; const bf16_t* vp = kp + 256;
#pragma unroll
            for (int q4 = 0; q4 < 4; ++q4) {
                const u32x4 w = *(const u32x4*)(kp + 8 * q4);
                kv[8 * q4 + 0] = bf2f(w.x & 0xffffu); kv[8 * q4 + 1] = bf2f(w.x >> 16); kv[8 * q4 + 2] = bf2f(w.y & 0xffffu); kv[8 * q4 + 3] = bf2f(w.y >> 16);
                kv[8 * q4 + 4] = bf2f(w.z & 0xffffu); kv[8 * q4 + 5] = bf2f(w.z >> 16); kv[8 * q4 + 6] = bf2f(w.w & 0xffffu); kv[8 * q4 + 7] = bf2f(w.w >> 16);
                const u32x4 x = *(const u32x4*)(vp + 8 * q4);
                vw[4 * q4 + 0] = x.x; vw[4 * q4 + 1] = x.y; vw[4 * q4 + 2] = x.z; vw[4 * q4 + 3] = x.w;
            }
        } else {
#pragma unroll
            for (int e = 0; e < 32; ++e) kv[e] = 0.f;
#pragma unroll
            for (int e = 0; e < 16; ++e) vw[e] = 0u;
        }
        float s = 0.f;
#pragma unroll
        for (int e = 0; e < 32; ++e) s += kv[e] * kv[e];
        s += __shfl_xor(s, 1);
        const float rstd = rsqrtf(s * (1.f / 64.f) + EPS);
        const float* kg = p.k_norm + l * 64 + half * 32;
#pragma unroll
        for (int e = 0; e < 32; ++e) kv[e] = kv[e] * rstd * kg[e];
#pragma unroll
        for (int q4 = 0; q4 < 4; ++q4)
            *(LAS u32x4*)(Kn + j * 72 + half * 32 + 8 * q4) = (u32x4){pk2(kv[8 * q4], kv[8 * q4 + 1]), pk2(kv[8 * q4 + 2], kv[8 * q4 + 3]), pk2(kv[8 * q4 + 4], kv[8 * q4 + 5]), pk2(kv[8 * q4 + 6], kv[8 * q4 + 7])};
#pragma unroll
        for (int e = 0; e < 16; ++e) { Vt[(half * 32 + 2 * e) * 264 + j] = (bf16_t)(vw[e] & 0xffffu); Vt[(half * 32 + 2 * e + 1) * 264 + j] = (bf16_t)(vw[e] >> 16); }
        if (blk == 15 && j >= 128) {
            float* pk = p.out + O_PK + ((((size_t)l * 4 + b) * 128 + (j - 128)) * 4 + hk) * 64 + half * 32;
            float* pv = p.out + O_PV + ((((size_t)l * 4 + b) * 128 + (j - 128)) * 4 + hk) * 64 + half * 32;
#pragma unroll
            for (int q4 = 0; q4 < 8; ++q4) {
                *(f32x4*)(pk + 4 * q4) = (f32x4){kv[4 * q4], kv[4 * q4 + 1], kv[4 * q4 + 2], kv[4 * q4 + 3]};
                *(f32x4*)(pv + 4 * q4) = (f32x4){bf2f(vw[2 * q4] & 0xffffu), bf2f(vw[2 * q4] >> 16), bf2f(vw[2 * q4 + 1] & 0xffffu), bf2f(vw[2 * q4 + 1] >> 16)};
            }
        }
        BT[tid] = p.rel_bias[t5_bucket(tid & 127) * 16 + hk * 4 + (tid >> 7)];
    }
    __syncthreads();
    const int g = wid >> 1, hq = hk * 4 + g;
    const float sink = p.sinks[l * 16 + hq];
    const float* qg = p.q_norm + l * 64;
    for (int task = 0; task < 2; ++task) {
        const int rg = 2 * (wid & 1) + task;
        bf16x8 qf[2][2];
#pragma unroll
        for (int qt = 0; qt < 2; ++qt) {
            const size_t r = (size_t)b * SEQ + blk * 128 + 32 * rg + 16 * qt + l15;
            float x[2][8]; float s = 0.f;
#pragma unroll
            for (int kk = 0; kk < 2; ++kk) {
                const u32x4 w = *(const u32x4*)(U + r * INW + 4096 + hq * 64 + 32 * kk + 8 * quad);
                x[kk][0] = bf2f(w.x & 0xffffu); x[kk][1] = bf2f(w.x >> 16); x[kk][2] = bf2f(w.y & 0xffffu); x[kk][3] = bf2f(w.y >> 16);
                x[kk][4] = bf2f(w.z & 0xffffu); x[kk][5] = bf2f(w.z >> 16); x[kk][6] = bf2f(w.w & 0xffffu); x[kk][7] = bf2f(w.w >> 16);
#pragma unroll
                for (int e = 0; e < 8; ++e) s += x[kk][e] * x[kk][e];
            }
            s += __shfl_xor(s, 16); s += __shfl_xor(s, 32);
            const float rstd = rsqrtf(s * (1.f / 64.f) + EPS) * 0.125f;
#pragma unroll
            for (int kk = 0; kk < 2; ++kk) {
                const f32x4 g0 = *(const f32x4*)(qg + 32 * kk + 8 * quad), g1 = *(const f32x4*)(qg + 32 * kk + 8 * quad + 4);
                qf[qt][kk] = mk8(pk2(x[kk][0] * rstd * g0[0], x[kk][1] * rstd * g0[1]), pk2(x[kk][2] * rstd * g0[2], x[kk][3] * rstd * g0[3]),
                                 pk2(x[kk][4] * rstd * g1[0], x[kk][5] * rstd * g1[1]), pk2(x[kk][6] * rstd * g1[2], x[kk][7] * rstd * g1[3]));
            }
        }
        f32x4 sc[10][2];
#pragma unroll
        for (int kb = 0; kb < 2; ++kb) {
            bf16x8 kfr[5][2];
#pragma unroll
            for (int k5 = 0; k5 < 5; ++k5) {
                const LAS bf16_t* kp = Kn + (16 * (2 * rg + 5 * kb + k5) + l15) * 72 + 8 * quad;
                kfr[k5][0] = *(const LAS bf16x8*)kp; kfr[k5][1] = *(const LAS bf16x8*)(kp + 32);
            }
            __builtin_amdgcn_sched_barrier(0);
#pragma unroll
            for (int k5 = 0; k5 < 5; ++k5)
#pragma unroll
                for (int qt = 0; qt < 2; ++qt) { f32x4 a = (f32x4){0.f, 0.f, 0.f, 0.f}; a = MFMA16(kfr[k5][0], qf[qt][0], a); a = MFMA16(kfr[k5][1], qf[qt][1], a); sc[5 * kb + k5][qt] = a; }
        }
        float mx[2] = {-3.0e38f, -3.0e38f};
#pragma unroll
        for (int kt = 0; kt < 10; ++kt)
#pragma unroll
            for (int qt = 0; qt < 2; ++qt)
#pragma unroll
                for (int j = 0; j < 4; ++j) {
                    const int jk = 16 * (2 * rg + kt) + 4 * quad + j, qi = 32 * rg + 16 * qt + l15, dist = 128 + qi - jk;
                    const bool valid = ((unsigned)dist < 128u) && (blk > 0 || jk >= 128);
                    const float s = valid ? sc[kt][qt][j] + BT[g * 128 + (dist & 127)] : -1e30f;
                    sc[kt][qt][j] = s; mx[qt] = fmaxf(mx[qt], s);
                }
        float sm[2];
#pragma unroll
        for (int qt = 0; qt < 2; ++qt) {
            float m = mx[qt]; m = fmaxf(m, __shfl_xor(m, 16)); m = fmaxf(m, __shfl_xor(m, 32)); m = fmaxf(m, sink); mx[qt] = m;
            float s = 0.f;
#pragma unroll
            for (int kt = 0; kt < 10; ++kt)
#pragma unroll
                for (int j = 0; j < 4; ++j) { const float e = __expf(sc[kt][qt][j] - m); sc[kt][qt][j] = e; s += e; }
            s += __shfl_xor(s, 16); s += __shfl_xor(s, 32);
            sm[qt] = 1.f / (s + __expf(sink - m));
        }
        bf16x8 pf[5][2];
#pragma unroll
        for (int g5 = 0; g5 < 5; ++g5)
#pragma unroll
            for (int qt = 0; qt < 2; ++qt) {
                const f32x4 a = sc[2 * g5][qt] * sm[qt], c2 = sc[2 * g5 + 1][qt] * sm[qt];
                pf[g5][qt] = mk8(pk2(a[0], a[1]), pk2(a[2], a[3]), pk2(c2[0], c2[1]), pk2(c2[2], c2[3]));
            }
#pragma unroll
        for (int dt = 0; dt < 4; ++dt) {
            f32x4 o0 = (f32x4){0.f, 0.f, 0.f, 0.f}, o1 = (f32x4){0.f, 0.f, 0.f, 0.f};
            bf16x8 vfr[5];
#pragma unroll
            for (int g5 = 0; g5 < 5; ++g5) {
                const LAS bf16_t* vp = Vt + (16 * dt + l15) * 264 + 16 * (2 * rg + 2 * g5) + 4 * quad;
                vfr[g5] = ld8x2(vp, vp + 16);
            }
            __builtin_amdgcn_sched_barrier(0);
#pragma unroll
            for (int g5 = 0; g5 < 5; ++g5) { o0 = MFMA16(vfr[g5], pf[g5][0], o0); o1 = MFMA16(vfr[g5], pf[g5][1], o1); }
            const size_t r0 = (size_t)b * SEQ + blk * 128 + 32 * rg + l15;
            *(u32x2*)(MIX + r0 * DM + 1024 + hq * 64 + 16 * dt + 4 * quad) = (u32x2){pk2(o0[0], o0[1]), pk2(o0[2], o0[3])};
            *(u32x2*)(MIX + (r0 + 16) * DM + 1024 + hq * 64 + 16 * dt + 4 * quad) = (u32x2){pk2(o1[0], o1[1]), pk2(o1[2], o1[3])};
        }
    }
    LBAR();
}

__device__ __forceinline__ void hgrn_sample_item(const Params& p, int l, int b, int h, LAS unsigned char* lds) {
    const int tid = tid_opaque(), lane = tid & 63, wid = tid >> 6;
    const int dv4 = tid & 31, dkg = tid >> 5;
    LAS float* RED = (LAS float*)lds;
    LAS float* SSW = (LAS float*)(lds + 32768);
    const bf16_t* U = (const bf16_t*)(p.ws + WS_U); const float* LF = (const float*)(p.ws + WS_LF); bf16_t* MIX = (bf16_t*)(p.ws + WS_MIX);
    const float* s0 = p.state + (((size_t)l * 32 + b) * 8 + h) * 16384;
    float* s1 = p.out + O_SS + (((size_t)l * 32 + b) * 8 + h) * 16384;
    f32x4 S[8];
#pragma unroll
    for (int i = 0; i < 8; ++i) S[i] = __builtin_nontemporal_load((const f32x4*)(s0 + (8 * dkg + i) * 128 + 4 * dv4));
#pragma unroll
    for (int t = 0; t < 4; ++t) {
        const size_t r = NPROMPT + b * 4 + t;
        const u32x2 vw = *(const u32x2*)(U + r * INW + 2048 + h * 128 + 4 * dv4);
        const f32x4 v = (f32x4){bf2f(vw.x & 0xffffu), bf2f(vw.x >> 16), bf2f(vw.y & 0xffffu), bf2f(vw.y >> 16)};
        f32x4 o = (f32x4){0.f, 0.f, 0.f, 0.f};
#pragma unroll
        for (int i = 0; i < 8; ++i) {
            const int dk = 8 * dkg + i;
            const float f = __expf(LF[r * 1024 + h * 128 + dk]);
            const float k = bf2f(U[r * INW + 1024 + h * 128 + dk]), q = bf2f(U[r * INW + h * 128 + dk]);
            S[i] = S[i] * f + v * k;
            o += S[i] * q;
        }
        *(LAS f32x4*)(RED + (t * 16 + dkg) * 128 + 4 * dv4) = o;
    }
#pragma unroll
    for (int i = 0; i < 8; ++i) __builtin_nontemporal_store(S[i], (f32x4*)(s1 + (8 * dkg + i) * 128 + 4 * dv4));
    LBAR();
    const int t = tid >> 7, dv = tid & 127;
    float o = 0.f;
#pragma unroll
    for (int i = 0; i < 16; ++i) o += RED[(t * 16 + i) * 128 + dv];
    const float ws_ = wave_sum(o * o);
    if (lane == 0) SSW[wid] = ws_;
    LBAR();
    const float ss = SSW[2 * t] + SSW[2 * t + 1];
    const float rstd = rsqrtf(ss * (1.f / 128.f) + EPS);
    const size_t r = NPROMPT + b * 4 + t;
    const float gate = bf2f(U[r * INW + 3072 + h * 128 + dv]);
    MIX[r * DM + h * 128 + dv] = (bf16_t)(pk2(o * rstd * p.hgrn_norm[l * 128 + dv] * gate, 0.f) & 0xffffu);
    LBAR();
}

__device__ __forceinline__ void attn_sample_item(const Params& p, int l, int b, int hk, LAS unsigned char* lds) {
    const int tid = tid_opaque(), lane = tid & 63, wid = tid >> 6;
    LAS float* KS = (LAS float*)lds;
    LAS float* VS = (LAS float*)(lds + 34320);
    LAS float* QS = (LAS float*)(lds + 34320 + 33792);
    LAS float* SC = (LAS float*)(lds + 34320 + 33792 + 4160);
    const bf16_t* U = (const bf16_t*)(p.ws + WS_U); bf16_t* MIX = (bf16_t*)(p.ws + WS_MIX);
    const float* ck = p.cache_k + (((size_t)l * 32 + b) * 128) * 256 + hk * 64;
    const float* cv = p.cache_v + (((size_t)l * 32 + b) * 128) * 256 + hk * 64;
    for (int idx = tid; idx < 128 * 64; idx += 512) { const int j = idx >> 6, d = idx & 63; KS[j * 65 + d] = __builtin_nontemporal_load(&ck[(size_t)j * 256 + d]); VS[j * 64 + d] = __builtin_nontemporal_load(&cv[(size_t)j * 256 + d]); }
    if (wid < 4) {
        const size_t r = NPROMPT + b * 4 + wid;
        const float x = bf2f(U[r * INW + 5120 + hk * 64 + lane]);
        const float rstd = rsqrtf(wave_sum(x * x) * (1.f / 64.f) + EPS);
        KS[(128 + wid) * 65 + lane] = x * rstd * p.k_norm[l * 64 + lane];
        VS[(128 + wid) * 64 + lane] = bf2f(U[r * INW + 5376 + hk * 64 + lane]);
    }
#pragma unroll
    for (int i = 0; i < 2; ++i) {
        const int qi = 2 * wid + i, t = qi >> 2, g = qi & 3;
        const size_t r = NPROMPT + b * 4 + t;
        const float x = bf2f(U[r * INW + 4096 + (hk * 4 + g) * 64 + lane]);
        const float rstd = rsqrtf(wave_sum(x * x) * (1.f / 64.f) + EPS);
        QS[qi * 65 + lane] = x * rstd * p.q_norm[l * 64 + lane] * 0.125f;
    }
    __syncthreads();
    {
        float* sk = p.out + O_SK + (((size_t)l * 32 + b) * 128) * 256 + hk * 64;
        float* sv = p.out + O_SV + (((size_t)l * 32 + b) * 128) * 256 + hk * 64;
        for (int idx = tid; idx < 128 * 64; idx += 512) { const int j = idx >> 6, d = idx & 63; __builtin_nontemporal_store(KS[(j + 4) * 65 + d], &sk[(size_t)j * 256 + d]); __builtin_nontemporal_store(VS[(j + 4) * 64 + d], &sv[(size_t)j * 256 + d]); }
    }
    for (int pi = tid; pi < 16 * 132; pi += 512) {
        const int qi = pi / 132, j = pi - qi * 132, t = qi >> 2, g = qi & 3, dist = 128 + t - j;
        float s = 0.f;
#pragma unroll 8
        for (int d = 0; d < 64; ++d) s += QS[qi * 65 + d] * KS[j * 65 + d];
        const bool valid = (unsigned)dist < 128u;
        SC[qi * 136 + j] = valid ? s + p.rel_bias[t5_bucket(dist & 127) * 16 + hk * 4 + g] : -1e30f;
    }
    __syncthreads();
#pragma unroll
    for (int i = 0; i < 2; ++i) {
        const int qi = 2 * wid + i, g = qi & 3;
        const float sink = p.sinks[l * 16 + hk * 4 + g];
        const float a0 = SC[qi * 136 + lane], a1 = SC[qi * 136 + 64 + lane], a2 = (lane < 4) ? SC[qi * 136 + 128 + lane] : -1e30f;
        const float m = fmaxf(wave_max(fmaxf(fmaxf(a0, a1), a2)), sink);
        const float e0 = __expf(a0 - m), e1 = __expf(a1 - m), e2 = (lane < 4) ? __expf(a2 - m) : 0.f;
        const float inv = 1.f / (wave_sum(e0 + e1 + e2) + __expf(sink - m));
        SC[qi * 136 + lane] = e0 * inv; SC[qi * 136 + 64 + lane] = e1 * inv; if (lane < 4) SC[qi * 136 + 128 + lane] = e2 * inv;
    }
    __syncthreads();
#pragma unroll
    for (int i = 0; i < 2; ++i) {
        const int pi = tid + 512 * i, qi = pi >> 6, d = pi & 63, t = qi >> 2, g = qi & 3;
        float o = 0.f;
        for (int j = 0; j < 132; ++j) o += SC[qi * 136 + j] * VS[j * 64 + d];
        const size_t r = NPROMPT + b * 4 + t;
        MIX[r * DM + 1024 + (hk * 4 + g) * 64 + d] = (bf16_t)(pk2(o, 0.f) & 0xffffu);
    }
    LBAR();
}

__device__ __forceinline__ void mix_other(const Params& p, int l, int j, LAS unsigned char* lds) {
    if (j < 256) { hgrn_sample_item(p, l, j >> 3, j & 7, lds); return; } j -= 256;
    attn_sample_item(p, l, j >> 2, j & 3, lds);
}
template <int K>
__device__ __forceinline__ void sample_tail(LAS unsigned char* lds, const bf16_t* A, const bf16_t* Bt, float* X, bf16_t* XB, unsigned long long* ssq, float* outp, bool dry = false, int first = -1, int stride = 0) {
    const int tid = tid_opaque(), lane = tid & 63, wid = __builtin_amdgcn_readfirstlane(tid >> 6), l15 = lane & 15, quad = lane >> 4;
    constexpr int KW = K / 8, NKS = KW / 32, NG = NKS / 2;
    LAS f32x4* RED = (LAS f32x4*)lds;
    if (first < 0) { first = blockIdx.x; stride = gridDim.x; }
    for (int piece = first; piece < 256; piece += stride) {
        const int row0 = NPROMPT + 64 * (piece & 1), col0 = 16 * (piece >> 1);
        const bf16_t* ap = A + (size_t)(row0 + l15) * K + wid * KW + 8 * quad;
        const bf16_t* bp = Bt + (size_t)(col0 + l15) * K + wid * KW + 8 * quad;
        f32x4 acc[4];
#pragma unroll
        for (int m = 0; m < 4; ++m) acc[m] = (f32x4){0.f, 0.f, 0.f, 0.f};
        bf16x8 ra[3][2][4], rb[3][2];
#define TL_LOAD(slot, g_) do { _Pragma("unroll") for (int s2 = 0; s2 < 2; ++s2) { rb[slot][s2] = *(const bf16x8*)(bp + 64 * (g_) + 32 * s2); \
            _Pragma("unroll") for (int m = 0; m < 4; ++m) ra[slot][s2][m] = *(const bf16x8*)(ap + (size_t)(16 * m) * K + 64 * (g_) + 32 * s2); } } while (0)
        TL_LOAD(0, 0); if (NG > 1) TL_LOAD(1, 1);
#pragma unroll
        for (int g = 0; g < NG; ++g) {
            if (g + 2 < NG) TL_LOAD((g + 2) % 3, g + 2);
#pragma unroll
            for (int s2 = 0; s2 < 2; ++s2)
#pragma unroll
                for (int m = 0; m < 4; ++m) acc[m] = MFMA16(rb[g % 3][s2], ra[g % 3][s2][m], acc[m]);
        }
#undef TL_LOAD
#pragma unroll
        for (int m = 0; m < 4; ++m) RED[(wid * 4 + m) * 64 + lane] = acc[m];
        __syncthreads();
        if (wid < 4) {
            f32x4 v = RED[wid * 64 + lane];
#pragma unroll
            for (int w = 1; w < 8; ++w) v += RED[(w * 4 + wid) * 64 + lane];
            const int row = row0 + 16 * wid + l15, col = col0 + 4 * quad;
            const u32x2 xw = *(const u32x2*)(XB + (size_t)row * DM + col);
            const f32x4 x = (f32x4){bf2f(xw.x & 0xffffu), bf2f(xw.x >> 16), bf2f(xw.y & 0xffffu), bf2f(xw.y >> 16)} + v;
            if (dry) { if (x[0] == 1.2345e30f) XB[0] = 1; }
            else if (outp) { *(f32x4*)(outp + (size_t)row * DM + col) = x; }
            else {
                *(u32x2*)(XB + (size_t)row * DM + col) = (u32x2){pk2(x[0], x[1]), pk2(x[2], x[3])};
                float sq = (x[0] * x[0] + x[1] * x[1]) + (x[2] * x[2] + x[3] * x[3]);
                sq += __shfl_xor(sq, 16); sq += __shfl_xor(sq, 32);
                if (quad == 0) atomicAdd(ssq + row, (unsigned long long)(sq * SSQ_SCALE));
            }
        }
        __syncthreads();
    }
}


__device__ __forceinline__ void mix_phase_a(const Params& p, int l, LAS unsigned char* lds) {
    for (int j = blockIdx.x; j < 1024; j += gridDim.x) prep_item(p, l, j, lds);
}
__device__ __forceinline__ void mix_phase_b(const Params& p, int l, LAS unsigned char* lds) {
    const int G = gridDim.x, c = blockIdx.x;
    if (G > 64) {
        if (c < 32) scan2_item(p, l, c >> 3, c & 7, lds);
        else {
            unsigned char* wl = p.ws + WS_W + (size_t)l * W_LAYER;
            unsigned* cnt = (unsigned*)(p.ws + WS_CNT) + l * 64;
            for (int j = c - 32; j < 384; j += G - 32) {
                mix_other(p, l, j, lds);
                asm volatile("s_waitcnt vmcnt(0)" ::: "memory"); __syncthreads();
                if (threadIdx.x == 0) { __builtin_amdgcn_fence(__ATOMIC_RELEASE, "agent"); asm volatile("s_waitcnt vmcnt(0)" ::: "memory");
                    __hip_atomic_fetch_add(cnt, 1u, __ATOMIC_RELAXED, __HIP_MEMORY_SCOPE_AGENT); }
            }
            for (int j = c - 32; j < 256; j += G - 32) attn_item(p, l, j >> 6, (j >> 2) & 15, j & 3, lds);
            convert_weights(p, lds, l, (c - 32) * 8 + __builtin_amdgcn_readfirstlane((int)(threadIdx.x >> 6)), (G - 32) * 8, CVT_SPLIT + CVT_QIN, CVT_ALL);
            __syncthreads();
            if (threadIdx.x == 0) {
                unsigned sp = 0; while (__hip_atomic_load(cnt, __ATOMIC_RELAXED, __HIP_MEMORY_SCOPE_AGENT) < 384u) { __builtin_amdgcn_s_sleep(2); if (++sp > (1u << 24)) break; }
            }
            __syncthreads();
            __builtin_amdgcn_fence(__ATOMIC_ACQUIRE, "agent");
            sample_tail<DM>(lds, (const bf16_t*)(p.ws + WS_MIX), (const bf16_t*)(wl + W_OUT_OFF), nullptr, (bf16_t*)(p.ws + WS_XB), (unsigned long long*)(p.ws + WS_SSQ) + (size_t)(2 * l + 1) * MP, nullptr, false, c - 32, G - 32);
        }
    } else {
        for (int j = c; j < 32; j += G) scan2_item(p, l, j >> 3, j & 7, lds);
        unsigned char* wl = p.ws + WS_W + (size_t)l * W_LAYER;
        unsigned* cnt = (unsigned*)(p.ws + WS_CNT) + l * 64;
        for (int j = c; j < 384; j += G) {
            mix_other(p, l, j, lds);
            asm volatile("s_waitcnt vmcnt(0)" ::: "memory"); __syncthreads();
            if (threadIdx.x == 0) { __builtin_amdgcn_fence(__ATOMIC_RELEASE, "agent"); asm volatile("s_waitcnt vmcnt(0)" ::: "memory");
                __hip_atomic_fetch_add(cnt, 1u, __ATOMIC_RELAXED, __HIP_MEMORY_SCOPE_AGENT); }
        }
        for (int j = c; j < 256; j += G) attn_item(p, l, j >> 6, (j >> 2) & 15, j & 3, lds);
        convert_weights(p, lds, l, c * 8 + __builtin_amdgcn_readfirstlane((int)(threadIdx.x >> 6)), G * 8, CVT_SPLIT + CVT_QIN, CVT_ALL);
        __syncthreads();
        if (threadIdx.x == 0) { unsigned sp = 0; while (__hip_atomic_load(cnt, __ATOMIC_RELAXED, __HIP_MEMORY_SCOPE_AGENT) < 384u) { __builtin_amdgcn_s_sleep(2); if (++sp > (1u << 24)) break; } }
        __syncthreads();
        __builtin_amdgcn_fence(__ATOMIC_ACQUIRE, "agent");
        sample_tail<DM>(lds, (const bf16_t*)(p.ws + WS_MIX), (const bf16_t*)(wl + W_OUT_OFF), nullptr, (bf16_t*)(p.ws + WS_XB), (unsigned long long*)(p.ws + WS_SSQ) + (size_t)(2 * l + 1) * MP, nullptr);
    }
}

#define XB_TMO      128
#define XB_XCNT(j)  (256  + 64 * (j))
#define XB_XSUB(j)  (1280 + 64 * (j))
#define XB_XGEN(j)  (2304 + 64 * (j))
#define XB_TOP      3328
#define XB_TOPGEN   3392
#define XCD_BAR_WORDS 3456
#define XB_SPIN_CAP (1u << 22)
__device__ __forceinline__ unsigned xb_ld(unsigned* p)              { return __hip_atomic_load(p, __ATOMIC_RELAXED, __HIP_MEMORY_SCOPE_AGENT); }
__device__ __forceinline__ unsigned xb_add(unsigned* p, unsigned v) { return __hip_atomic_fetch_add(p, v, __ATOMIC_RELAXED, __HIP_MEMORY_SCOPE_AGENT); }
__device__ __forceinline__ unsigned xb_xcc_id() { return (unsigned)__builtin_amdgcn_s_getreg((3 << 11) | 20) & 0xFu; }
#define XB_SPIN(cond, bar) do { unsigned _sp = 0; while (cond) { __builtin_amdgcn_s_sleep(1); \
    if ((++_sp & 255u) == 0u) { if (xb_ld(&(bar)[XB_TMO])) break; if (_sp > XB_SPIN_CAP) { atomicAdd(&(bar)[XB_TMO], 1u); break; } } } } while (0)
struct XcdBarrier { unsigned* bar; unsigned x; volatile LAS unsigned* st; };
__device__ __forceinline__ XcdBarrier xcd_barrier_post(unsigned* bar, volatile LAS unsigned* st) {
    XcdBarrier b; b.bar = bar; b.x = xb_xcc_id(); b.st = st;
    if (threadIdx.x == 0) (void)xb_add(&bar[XB_XCNT(b.x)], 1u);
    return b;
}
__device__ __forceinline__ void xcd_barrier_complete(unsigned* bar, unsigned x, unsigned& nloc, unsigned& nx) {
    const unsigned G = gridDim.x * gridDim.y * gridDim.z;
    unsigned sum, cnt, mine, sp = 0u;
    for (;;) {
        sum = 0u; cnt = 0u; mine = 0u;
#pragma unroll
        for (unsigned j = 0; j < 16; ++j) { const unsigned c = xb_ld(&bar[XB_XCNT(j)]); sum += c; cnt += (c > 0u) ? 1u : 0u; mine = (j == x) ? c : mine; }
        if (sum == G) break;
        __builtin_amdgcn_s_sleep(1);
        if ((++sp & 255u) == 0u) { if (xb_ld(&bar[XB_TMO])) break; if (sp > XB_SPIN_CAP) { atomicAdd(&bar[XB_TMO], 1u); break; } }
    }
    nloc = mine > 0u ? mine : 1u; nx = cnt > 0u ? cnt : 1u;
}
__device__ __forceinline__ void xcd_barrier(const XcdBarrier& b) {
    asm volatile("s_waitcnt vmcnt(0)" ::: "memory");
    __syncthreads();
    if (threadIdx.x == 0) {
        unsigned* bar = b.bar;
        __builtin_amdgcn_s_waitcnt(0);
        unsigned nloc = b.st[0], nx = b.st[1];
        if (nloc == 0u) { xcd_barrier_complete(bar, b.x, nloc, nx); b.st[0] = nloc; b.st[1] = nx; }
        const unsigned old = xb_add(&bar[XB_XSUB(b.x)], 1u);
        const unsigned gen = old / nloc;
        if (old + 1u == (gen + 1u) * nloc) {
            __builtin_amdgcn_fence(__ATOMIC_RELEASE, "agent");
            asm volatile("s_waitcnt vmcnt(0)" ::: "memory");
            const unsigned og = xb_add(&bar[XB_TOP], 1u);
            const unsigned tg = og / nx;
            if (og + 1u == (tg + 1u) * nx) xb_add(&bar[XB_TOPGEN], 1u);
            else XB_SPIN(xb_ld(&bar[XB_TOPGEN]) == tg, bar);
            __builtin_amdgcn_fence(__ATOMIC_ACQUIRE, "agent");
            xb_add(&bar[XB_XGEN(b.x)], 1u);
            asm volatile("s_waitcnt vmcnt(0)" ::: "memory");
        } else {
            XB_SPIN(xb_ld(&bar[XB_XGEN(b.x)]) == gen, bar);
            __builtin_amdgcn_fence(__ATOMIC_ACQUIRE, "agent");
            asm volatile("s_waitcnt vmcnt(0)" ::: "memory");
        }
    }
    __syncthreads();
}

__global__ void __launch_bounds__(512, 2) fwd_mega(Params p) {
    extern __shared__ __attribute__((aligned(16))) unsigned char lds_raw[];
    LAS unsigned char* lds = (LAS unsigned char*)lds_raw;
    cg::grid_group grid = cg::this_grid();
    unsigned char* ws = p.ws;
    const int lo = p.ph_lo, hi = p.ph_hi, G = gridDim.x;
    int ph = 0;
    unsigned* barw = (unsigned*)(ws + WS_BAR);
    volatile LAS unsigned* bst = (volatile LAS unsigned*)(lds + LDS_BYTES - 64);
    if (threadIdx.x == 0) { bst[0] = 0u; bst[1] = 0u; }
    if (blockIdx.x == 0) { for (int i = threadIdx.x; i < XCD_BAR_WORDS; i += 512) barw[i] = 0u; if (threadIdx.x < 4) ((unsigned*)(ws + WS_CNT))[threadIdx.x * 64] = 0u; }
    XcdBarrier xbar; xbar.bar = barw; xbar.x = 0; xbar.st = bst;
#define SEAM() do { if (ph >= lo && ph + 1 < hi) { if (ph == lo) { grid.sync(); xbar = xcd_barrier_post(barw, bst); } else { xcd_barrier(xbar); if (PROBE_SYNC2) xcd_barrier(xbar); } } ++ph; } while (0)
#define IN() (ph >= lo && ph < hi)
    if (IN()) { prologue(p, lds); if (PROBE_PRO2) { __syncthreads(); prologue(p, lds); } }
    SEAM();
    for (int l = 0; l < DEPTH; ++l) {
        unsigned char* wl = ws + WS_W + (size_t)l * W_LAYER;
        unsigned long long* ssq = (unsigned long long*)(ws + WS_SSQ);
        if (IN()) {
            pg8::Gemm g{(const bf16_t*)(ws + WS_XB), (const bf16_t*)(wl + W_IN_OFF), MP, INW, DM}; pg8::StaticOrder S; S.init(MP, INW, G, bid_opaque());
            EpiIn E{(bf16_t*)(ws + WS_U), (float*)(ws + WS_LF), ssq + (size_t)(2 * l) * MP, (const float*)(ws + WS_LB) + l * 1024};
            pg8::gemm_phase<EpiIn>(lds, g, S, E);
            {
                const int nfull = S.nwg % G, c = blockIdx.x;
                if (nfull != 0 && c >= nfull) convert_weights(p, lds, l, (c - nfull) * 8 + __builtin_amdgcn_readfirstlane((int)(threadIdx.x >> 6)), (G - nfull) * 8, CVT_SPLIT, CVT_SPLIT + CVT_QIN);
                else if (nfull == 0) convert_weights(p, lds, l, c * 8 + __builtin_amdgcn_readfirstlane((int)(threadIdx.x >> 6)), G * 8, CVT_SPLIT, CVT_SPLIT + CVT_QIN);
            }
            if (PROBE_IN2 == 1) { __syncthreads(); pg8::gemm_phase<EpiIn>(lds, g, S, E); }
        }
        SEAM();
        if (IN()) { mix_phase_a(p, l, lds); if (PROBE_MIX2 == 1) { __syncthreads(); mix_phase_a(p, l, lds); } }
        SEAM();
        if (IN()) { mix_phase_b(p, l, lds); if (PROBE_MIX2 == 2 || (PROBE_MIX2 == 3 && blockIdx.x < 32) || (PROBE_MIX2 == 4 && blockIdx.x >= 32)) { __syncthreads(); mix_phase_b(p, l, lds); } }
        SEAM();
        if (IN()) {
            pg8::Gemm g{(const bf16_t*)(ws + WS_MIX), (const bf16_t*)(wl + W_OUT_OFF), NPROMPT, DM, DM}; pg8::StaticOrder S; S.init(NPROMPT, DM, G, bid_opaque());
            EpiRes E{(bf16_t*)(ws + WS_XB), ssq + (size_t)(2 * l + 1) * MP, nullptr};
            pg8::gemm_phase<EpiRes>(lds, g, S, E);
            if (PROBE_ND == 1) { __syncthreads(); EpiNull EN{(float*)(ws + WS_LB) + 8192}; pg8::gemm_phase<EpiNull>(lds, g, S, EN); }
            if (PROBE_ND == 2) sample_tail<DM>(lds, (const bf16_t*)(ws + WS_MIX), (const bf16_t*)(wl + W_OUT_OFF), (float*)(ws + WS_X), (bf16_t*)(ws + WS_XB), ssq + (size_t)(2 * l + 1) * MP, nullptr, true);
        }
        SEAM();
        if (IN()) {
            pg8::Gemm g{(const bf16_t*)(ws + WS_XB), (const bf16_t*)(wl + W_GU_OFF), MP, 2 * FFW, DM}; pg8::StaticOrder S; S.init(MP, 2 * FFW, G, bid_opaque());
            EpiGU E{(bf16_t*)(ws + WS_ACT), ssq + (size_t)(2 * l + 1) * MP};
            pg8::gemm_phase<EpiGU>(lds, g, S, E);
            if (l + 1 < DEPTH) {
                const int nfull = S.nwg % G, c = blockIdx.x;
                if (nfull != 0 && c >= nfull) convert_weights(p, lds, l + 1, (c - nfull) * 8 + __builtin_amdgcn_readfirstlane((int)(threadIdx.x >> 6)), (G - nfull) * 8, 0, CVT_SPLIT);
                else if (nfull == 0) convert_weights(p, lds, l + 1, c * 8 + __builtin_amdgcn_readfirstlane((int)(threadIdx.x >> 6)), G * 8, 0, CVT_SPLIT);
            }
            if (PROBE_IN2 == 2) { __syncthreads(); pg8::gemm_phase<EpiGU>(lds, g, S, E); }
        }
        SEAM();
        if (IN()) {
            pg8::Gemm g{(const bf16_t*)(ws + WS_ACT), (const bf16_t*)(wl + W_DN_OFF), NPROMPT, DM, FFW}; pg8::StaticOrder S; S.init(NPROMPT, DM, G, bid_opaque());
            EpiRes E{(bf16_t*)(ws + WS_XB), ssq + (size_t)(2 * l + 2) * MP, (l == DEPTH - 1) ? p.out : nullptr};
            pg8::gemm_phase<EpiRes>(lds, g, S, E);
            if (PROBE_ND == 1) { __syncthreads(); EpiNull EN{(float*)(ws + WS_LB) + 8192}; pg8::gemm_phase<EpiNull>(lds, g, S, EN); }
            if (PROBE_ND == 2) sample_tail<FFW>(lds, (const bf16_t*)(ws + WS_ACT), (const bf16_t*)(wl + W_DN_OFF), (float*)(ws + WS_X), (bf16_t*)(ws + WS_XB), ssq + (size_t)(2 * l + 2) * MP, nullptr, true);
            sample_tail<FFW>(lds, (const bf16_t*)(ws + WS_ACT), (const bf16_t*)(wl + W_DN_OFF), (float*)(ws + WS_X), (bf16_t*)(ws + WS_XB), ssq + (size_t)(2 * l + 2) * MP, (l == DEPTH - 1) ? p.out : nullptr);
        }
        SEAM();
    }
#undef SEAM
#undef IN
}


#ifndef DBG_STOP
#define DBG_STOP 0
#endif
#ifndef DBG_NANCHK
#define DBG_NANCHK 0
#endif
#ifndef DBG_BUF
#define DBG_BUF 8
#endif
__global__ void dbg_dump(Params p) {
    const size_t n = 45350912; const size_t i0 = (size_t)blockIdx.x * blockDim.x + threadIdx.x, st = (size_t)gridDim.x * blockDim.x;
    for (size_t i = i0; i < n; i += st) {
        float v = 0.f;
        if (DBG_BUF == 1) v = bf2f(((const bf16_t*)(p.ws + WS_U))[i]);
        else if (DBG_BUF == 2) v = ((const float*)(p.ws + WS_LF))[i % ((size_t)MP * 1024)];
        else if (DBG_BUF == 3) v = bf2f(((const bf16_t*)(p.ws + WS_MIX))[i % ((size_t)MR * DM)]);
        else if (DBG_BUF == 4) v = ((const float*)(p.ws + WS_X))[i % ((size_t)MR * DM)];
        else if (DBG_BUF == 5) v = bf2f(((const bf16_t*)(p.ws + WS_ACT))[i]);
        else if (DBG_BUF == 6) v = bf2f(((const bf16_t*)(p.ws + WS_W))[i]);
        else if (DBG_BUF == 7) { const size_t j = i % ((size_t)NPROMPT * 1024); v = bf2f(((const bf16_t*)(p.ws + WS_MIX))[(j >> 10) * DM + (j & 1023)]); }
        else if (DBG_BUF == 8) { const size_t j = i % ((size_t)NPROMPT * 1024); v = bf2f(((const bf16_t*)(p.ws + WS_MIX))[(j >> 10) * DM + 1024 + (j & 1023)]); }
        else if (DBG_BUF == 9) { const size_t j = i % ((size_t)NSAMP * 1024); v = bf2f(((const bf16_t*)(p.ws + WS_MIX))[(NPROMPT + (j >> 10)) * DM + (j & 1023)]); }
        else if (DBG_BUF == 10) { const size_t j = i % ((size_t)NSAMP * 1024); v = bf2f(((const bf16_t*)(p.ws + WS_MIX))[(NPROMPT + (j >> 10)) * DM + 1024 + (j & 1023)]); }
        if (DBG_NANCHK) v = (fabsf(v) <= 3.0e38f) ? 0.f : 1.0e9f;
        p.out[i] = v;
    }
}
#ifndef N_LAUNCH_MODE
#define N_LAUNCH_MODE 1
#endif
extern "C" void kernel_launch(void* const* d_in, const int* in_sizes, int n_in, void* d_out, int out_size, void* d_ws, size_t ws_size, hipStream_t stream) {
    static int grid = 0;
    if (grid == 0) {
        if (n_in != 18 || ws_size < WS_END || out_size != 45350912) { fprintf(stderr, "kernel_launch: unexpected shapes: n_in %d out %d ws %zu\n", n_in, out_size, ws_size); grid = -1; return; }
        int dev = 0, cus = 0, per_cu = 0;
        hipGetDevice(&dev); hipDeviceGetAttribute(&cus, hipDeviceAttributeMultiprocessorCount, dev);
        if (hipFuncSetAttribute((const void*)fwd_mega, hipFuncAttributeMaxDynamicSharedMemorySize, LDS_BYTES) != hipSuccess) { fprintf(stderr, "kernel_launch: hipFuncSetAttribute failed\n"); grid = -1; return; }
        if (hipOccupancyMaxActiveBlocksPerMultiprocessor(&per_cu, (const void*)fwd_mega, 512, LDS_BYTES) != hipSuccess || per_cu < 1) { fprintf(stderr, "kernel_launch: occupancy query says %d\n", per_cu); per_cu = 1; }
        (void)hipGetLastError();
        grid = cus * 1;
        fprintf(stderr, "kernel_launch: grid %d (per_cu %d)\n", grid, per_cu);
    }
    if (grid < 0) return;
    Params p{};
    p.x_prompt = (const float*)d_in[0]; p.x_sample = (const float*)d_in[1]; p.cache_k = (const float*)d_in[2]; p.cache_v = (const float*)d_in[3]; p.state = (const float*)d_in[4];
    p.norm_mix = (const float*)d_in[5]; p.w_in = (const float*)d_in[6]; p.lower_bounds = (const float*)d_in[7]; p.hgrn_norm = (const float*)d_in[8]; p.q_norm = (const float*)d_in[9];
    p.k_norm = (const float*)d_in[10]; p.sinks = (const float*)d_in[11]; p.rel_bias = (const float*)d_in[12]; p.w_out = (const float*)d_in[13]; p.norm_ffn = (const float*)d_in[14];
    p.w_gate = (const float*)d_in[15]; p.w_up = (const float*)d_in[16]; p.w_down = (const float*)d_in[17];
    p.out = (float*)d_out; p.ws = (unsigned char*)d_ws;
#if N_LAUNCH_MODE == 1
    p.ph_lo = 0; p.ph_hi = 25;
    void* args[] = {&p};
    hipError_t e = hipLaunchCooperativeKernel((const void*)fwd_mega, dim3(grid), dim3(512), args, LDS_BYTES, stream);
    if (e != hipSuccess) fprintf(stderr, "cooperative launch failed: %s (grid %d)\n", hipGetErrorString(e), grid);
#else
    const int nph = DBG_STOP ? DBG_STOP : 25;
    for (int ph = 0; ph < nph; ++ph) { p.ph_lo = ph; p.ph_hi = ph + 1; hipLaunchKernelGGL(fwd_mega, dim3(grid), dim3(512), LDS_BYTES, stream, p); }
    if (DBG_STOP) hipLaunchKernelGGL(dbg_dump, dim3(2048), dim3(256), 0, stream, p);
#endif
}
```

```cpp
#include <hip/hip_runtime.h>
#include <hip/hip_cooperative_groups.h>
#include <cstdio>
#include <cstdint>
namespace cg = cooperative_groups;
#ifndef PROBE_MIX2
#define PROBE_MIX2 0
#endif
#ifndef PROBE_IN2
#define PROBE_IN2 0
#endif
#ifndef PROBE_ND
#define PROBE_ND 0
#endif
#ifndef PROBE_PRO2
#define PROBE_PRO2 0
#endif
#ifndef PROBE_SYNC2
#define PROBE_SYNC2 0
#endif


#define LAS __attribute__((address_space(3)))
typedef unsigned short bf16_t;
typedef short bf16x8 __attribute__((ext_vector_type(8)));
typedef float f32x4 __attribute__((ext_vector_type(4)));
typedef float f32x2 __attribute__((ext_vector_type(2)));
typedef unsigned u32x4 __attribute__((ext_vector_type(4)));
typedef unsigned u32x2 __attribute__((ext_vector_type(2)));

constexpr int DM = 2048, NPROMPT = 8192, NSAMP = 128, MR = NPROMPT + NSAMP  , MP = 8448  ;
constexpr int INW = 5632, FFW = 5632, DEPTH = 4, SEQ = 2048;
constexpr float EPS = 1e-6f, SSQ_SCALE = 1048576.f, SSQ_INV = 1.f / 1048576.f;
constexpr size_t O_YP = 0, O_YS = 16777216, O_PK = 17039360, O_PV = 17563648, O_PS = 18087936, O_SK = 20185088, O_SV = 24379392, O_SS = 28573696;
constexpr size_t MiB = 1u << 20;
constexpr size_t WS_LB = 0, WS_BAR = 720896  , WS_CNT = 737280  , WS_SSQ = 65536, WS_W = 1 * MiB, W_IN_OFF = 0, W_OUT_OFF = 22 * MiB, W_GU_OFF = 30 * MiB, W_DN_OFF = 74 * MiB, W_LAYER = 96 * MiB;
constexpr size_t WS_X = 385 * MiB, WS_XB = 451 * MiB, WS_U = 484 * MiB, WS_LF = 575 * MiB, WS_MIX = 608 * MiB, WS_ACT = 641 * MiB, WS_END = 732 * MiB;
constexpr int LDS_BYTES = 147456;
constexpr int CVT_QIN = 3000;
constexpr int CVT_SPLIT = 32 * 176 + 32 * 64, CVT_ALL = 32 * 176 * 3 + 32 * 64 + 88 * 64;


struct Params {
    const float *x_prompt, *x_sample, *cache_k, *cache_v, *state, *norm_mix, *w_in, *lower_bounds, *hgrn_norm, *q_norm, *k_norm, *sinks, *rel_bias, *w_out, *norm_ffn, *w_gate, *w_up, *w_down;
    float* out; unsigned char* ws;
    int ph_lo, ph_hi;
};

__device__ __forceinline__ int tid_opaque() { int t = threadIdx.x; asm volatile("" : "+v"(t)); return t; }
__device__ __forceinline__ int bid_opaque() { int t = blockIdx.x; asm volatile("" : "+s"(t)); return t; }
__device__ __forceinline__ float bf2f(unsigned u16) { return __uint_as_float(u16 << 16); }
typedef __bf16 bf16x2_t __attribute__((ext_vector_type(2)));
__device__ __forceinline__ unsigned pk2(float lo, float hi) { f32x2 v = {lo, hi}; bf16x2_t b = __builtin_convertvector(v, bf16x2_t); return __builtin_bit_cast(unsigned, b); }
__device__ __forceinline__ float silu_f(float x) { return x * __builtin_amdgcn_rcpf(1.f + __expf(-x)); }
__device__ __forceinline__ float wave_sum(float v) {
#pragma unroll
    for (int o = 1; o < 64; o <<= 1) v += __shfl_xor(v, o);
    return v;
}
__device__ __forceinline__ float wave_max(float v) {
#pragma unroll
    for (int o = 1; o < 64; o <<= 1) v = fmaxf(v, __shfl_xor(v, o));
    return v;
}
__device__ __forceinline__ int t5_bucket(int n) {
    if (n < 16) return n;
    int v = 16 + (int)(logf((float)n * 0.0625f) / 2.0794415416798357f * 16.f);
    return v < 31 ? v : 31;
}

namespace pg8 {
constexpr int BM = 256, BK = 64, HALF = 128, HTB = HALF * BK * 2, STAGE_BYTES = 8 * HTB, NXCD = 8, WGM = 8;
__host__ __device__ __forceinline__ int lds_byte(int r, int c) { const int st = (r >> 4) * 2 + (c >> 5), rr = r & 15, cc = c & 31, ob = rr * 64 + cc * 2; return st * 1024 + (ob ^ (((ob >> 9) & 1) << 5)); }
__host__ __device__ __forceinline__ void stage_rc(int b, int& R, int& C) { const int st = b / 1024, sb = b % 1024, swz = sb ^ (((sb >> 9) & 1) << 5); R = (st >> 1) * 16 + swz / 64; C = (st & 1) * 32 + (swz % 64) / 2; }
__host__ __device__ __forceinline__ int perm32(int rho) { const int n = rho >> 4, i = rho & 15; return 8 * (i >> 2) + 4 * n + (i & 3); }

struct Unit { int pm, pn; };
struct Gemm { const bf16_t* A; const bf16_t* Bt; int M, N, K; };

struct StaticOrder {
    int nM, nN, nwg, G, c;
    __host__ __device__ void init(int M, int N, int G_, int c_) { nM = M / BM; nN = N / BM; nwg = nM * nN; G = G_; c = c_; }
    __host__ __device__ bool next(int i, Unit& u) const {
        const long L = (long)i * G + c; if (L >= nwg) return false;
        int wgid = (int)L; { const int q = nwg / NXCD, r = nwg % NXCD, xcd = wgid % NXCD, off = wgid / NXCD; wgid = (xcd < r ? xcd * (q + 1) : r * (q + 1) + (xcd - r) * q) + off; }
        const int nig = WGM * nN, gid = wgid / nig, fm = gid * WGM, gsz = (nM - fm) < WGM ? (nM - fm) : WGM;
        u.pm = fm + ((wgid % nig) % gsz); u.pn = (wgid % nig) / gsz; return true;
    }
};

template <class Epi>
__device__ __forceinline__ void gemm_phase(LAS unsigned char* lds, const Gemm g, const StaticOrder& S, const Epi& E) {
    const int tid = tid_opaque(), wid = __builtin_amdgcn_readfirstlane(tid >> 6), lane = tid & 63, wr = wid >> 2, wc = wid & 3, fr = lane & 15, fq = lane >> 4;
    const int K = g.K, nt = K / BK;
    unsigned voffA[2], voffB[2];
#pragma unroll
    for (int i = 0; i < 2; ++i) { int R, C; stage_rc(tid * 16 + i * 8192, R, C); const int Rb = (R & ~31) + perm32(R & 31);
        voffA[i] = (unsigned)(R * K + C) * 2u; voffB[i] = (unsigned)(Rb * K + C) * 2u; }
    const size_t kstep = (size_t)(BK * 2);
    const size_t hstep = (size_t)HALF * K * 2;
    const size_t tstep = 2 * hstep;
    const unsigned ldsw = (unsigned)wid * 1024u;
    const int aoff = lds_byte(wr * 64 + fr, fq * 8), boff = lds_byte(wc * 32 + fr, fq * 8);
#define PG8_SA(b, h) (((b) * 2 + (h)) * HTB)
#define PG8_SB(b, h) ((4 + (b) * 2 + (h)) * HTB)
#define PG8_STAGE(bufoff, gbase, voff) do { _Pragma("unroll") for (int _i = 0; _i < 2; ++_i) \
        __builtin_amdgcn_global_load_lds((const unsigned*)((const char*)(gbase) + (voff)[_i]), (LAS unsigned*)(lds + (bufoff) + ldsw + _i * 8192), 16, 0, 0); } while (0)
#define PG8_LDA(dst, b, h) do { _Pragma("unroll") for (int m = 0; m < 4; ++m) _Pragma("unroll") for (int k = 0; k < 2; ++k) dst[m][k] = *(const LAS bf16x8*)(lds + PG8_SA(b, h) + aoff + m * 2048 + k * 1024); } while (0)
#define PG8_LDB(dst, b, h) do { _Pragma("unroll") for (int n = 0; n < 2; ++n) _Pragma("unroll") for (int k = 0; k < 2; ++k) dst[n][k] = *(const LAS bf16x8*)(lds + PG8_SB(b, h) + boff + n * 2048 + k * 1024); } while (0)
#define PG8_MMA(ai, bj, At, Bt) do { __builtin_amdgcn_s_setprio(1); _Pragma("unroll") for (int m = 0; m < 4; ++m) _Pragma("unroll") for (int n = 0; n < 2; ++n) _Pragma("unroll") for (int k = 0; k < 2; ++k) \
        acc[ai][bj][m][n] = __builtin_amdgcn_mfma_f32_16x16x32_bf16(Bt[n][k], At[m][k], acc[ai][bj][m][n], 0, 0, 0); __builtin_amdgcn_s_setprio(0); } while (0)
#define PG8_WAIT_V(n) asm volatile("s_waitcnt vmcnt(" #n ")" ::: "memory")
#define PG8_WAIT_L(n) asm volatile("s_waitcnt lgkmcnt(" #n ")" ::: "memory")
#define PG8_BAR __builtin_amdgcn_s_barrier()
#define PG8_SCHED __builtin_amdgcn_sched_barrier(0)
    Unit cur, nxt; int ui = 0;
    if (!S.next(0, cur)) return;
    f32x4 acc[2][2][4][2];
#pragma unroll
    for (int a = 0; a < 2; ++a)
#pragma unroll
        for (int b = 0; b < 2; ++b)
#pragma unroll
            for (int m = 0; m < 4; ++m)
#pragma unroll
                for (int n = 0; n < 2; ++n) acc[a][b][m][n] = (f32x4){0.f, 0.f, 0.f, 0.f};
    bf16x8 At[4][2], B0[2][2], B1[2][2];
    const char* cA = (const char*)g.A + (size_t)cur.pm * tstep; const char* cB = (const char*)g.Bt + (size_t)cur.pn * tstep;
    PG8_STAGE(PG8_SB(0, 0), cB, voffB); PG8_STAGE(PG8_SB(0, 1), cB + hstep, voffB); PG8_STAGE(PG8_SA(0, 0), cA, voffA); PG8_STAGE(PG8_SA(0, 1), cA + hstep, voffA);
    if (wr == 1) PG8_BAR;
    PG8_WAIT_V(2); PG8_BAR;
    PG8_STAGE(PG8_SB(1, 0), cB + kstep, voffB); PG8_STAGE(PG8_SA(1, 0), cA + kstep, voffA); PG8_STAGE(PG8_SB(1, 1), cB + hstep + kstep, voffB);
    PG8_WAIT_V(6); PG8_BAR;
    for (;;) {
        const bool has_next = S.next(ui + 1, nxt);
        const char* nA = has_next ? (const char*)g.A + (size_t)nxt.pm * tstep : cA; const char* nB = has_next ? (const char*)g.Bt + (size_t)nxt.pn * tstep : cB;
        for (int t = 0; t < nt; t += 2) {
            const bool last = (t == nt - 2);
            const char* a1 = cA + (size_t)(t + 1) * kstep;
            const char* a2 = last ? nA : cA + (size_t)(t + 2) * kstep; const char* b2 = last ? nB : cB + (size_t)(t + 2) * kstep;
            const char* a3 = a2 + kstep; const char* b3 = b2 + kstep;
            PG8_LDB(B0, 0, 0); PG8_LDB(B1, 0, 1); PG8_SCHED; PG8_LDA(At, 0, 0); PG8_STAGE(PG8_SA(1, 1), a1 + hstep, voffA);
            PG8_WAIT_V(8); PG8_WAIT_L(0); PG8_BAR; PG8_MMA(0, 0, At, B0); PG8_MMA(0, 1, At, B1); PG8_BAR; PG8_SCHED;
            PG8_LDA(At, 0, 1); PG8_STAGE(PG8_SB(0, 0), b2, voffB); PG8_STAGE(PG8_SB(0, 1), b2 + hstep, voffB); PG8_STAGE(PG8_SA(0, 0), a2, voffA);
            PG8_WAIT_V(8); PG8_WAIT_L(0); PG8_BAR; PG8_MMA(1, 0, At, B0); PG8_MMA(1, 1, At, B1); PG8_BAR; PG8_SCHED;
            PG8_LDB(B0, 1, 0); PG8_LDB(B1, 1, 1); PG8_SCHED; PG8_LDA(At, 1, 0); PG8_STAGE(PG8_SA(0, 1), a2 + hstep, voffA);
            PG8_WAIT_V(8); PG8_WAIT_L(0); PG8_BAR; PG8_MMA(0, 0, At, B0); PG8_MMA(0, 1, At, B1); PG8_BAR; PG8_SCHED;
            PG8_LDA(At, 1, 1); PG8_STAGE(PG8_SB(1, 0), b3, voffB); PG8_STAGE(PG8_SB(1, 1), b3 + hstep, voffB); PG8_STAGE(PG8_SA(1, 0), a3, voffA);
            PG8_WAIT_V(8); PG8_WAIT_L(0); PG8_BAR; PG8_MMA(1, 0, At, B0); PG8_MMA(1, 1, At, B1); PG8_BAR; PG8_SCHED;
        }
        if (wr == 0) PG8_BAR;
        E(acc, cur, wr, wc, fr, fq);
        if (!has_next) break;
#pragma unroll
        for (int a = 0; a < 2; ++a)
#pragma unroll
            for (int b = 0; b < 2; ++b)
#pragma unroll
                for (int m = 0; m < 4; ++m)
#pragma unroll
                    for (int n = 0; n < 2; ++n) acc[a][b][m][n] = (f32x4){0.f, 0.f, 0.f, 0.f};
        cur = nxt; cA = nA; cB = nB; ++ui;
        if (wr == 1) PG8_BAR;
    }
    PG8_WAIT_V(0);
    PG8_BAR;
#undef PG8_SA
#undef PG8_SB
#undef PG8_STAGE
#undef PG8_LDA
#undef PG8_LDB
#undef PG8_MMA
#undef PG8_WAIT_V
#undef PG8_WAIT_L
#undef PG8_BAR
#undef PG8_SCHED
}
}

struct EpiIn {
    bf16_t* U; float* LF; const unsigned long long* ssq; const float* lb;
    template <int MODE>
    __device__ __forceinline__ void body(const f32x4 (&acc)[2][2][4][2], const pg8::Unit& u, int wr, int wc, int fr, int fq) const {
        const int row0 = u.pm * 256 + wr * 64 + fr, colb = u.pn * 256 + wc * 32 + 8 * fq;
#pragma unroll
        for (int bj = 0; bj < 2; ++bj) {
            const int col = colb + bj * 128;
            f32x4 l0 = (f32x4){0.f, 0.f, 0.f, 0.f}, l1 = l0;
            if (MODE == 1) { l0 = *(const f32x4*)(lb + col - 1024); l1 = *(const f32x4*)(lb + col - 1020); }
#pragma unroll
            for (int ai = 0; ai < 2; ++ai)
#pragma unroll
                for (int m = 0; m < 4; ++m) {
                    const int row = row0 + ai * 128 + m * 16;
                    const float rstd = rsqrtf((float)ssq[row] * (SSQ_INV / DM) + EPS);
                    float v[8];
#pragma unroll
                    for (int e = 0; e < 8; ++e) v[e] = acc[ai][bj][m][e >> 2][e & 3] * rstd;
                    if (MODE == 0) {
#pragma unroll
                        for (int e = 0; e < 8; ++e) v[e] = silu_f(v[e]);
                    } else if (MODE == 1) {
                        float lf[8];
#pragma unroll
                        for (int e = 0; e < 8; ++e) {
                            const float z = v[e], l = (e < 4) ? l0[e & 3] : l1[e & 3];
                            const float ez = __expf(-fabsf(z));
                            const float inv = __builtin_amdgcn_rcpf(1.f + ez);
                            const float big = inv, small = ez * inv;
                            const float sp = (z >= 0.f) ? big : small;
                            const float sn = (z >= 0.f) ? small : big;
                            const float lsig = fminf(z, 0.f) - __logf(1.f + ez);
                            lf[e] = (l > 0.f) ? __logf(l + (1.f - l) * sp) : lsig;
                            v[e] = (1.f - l) * sn;
                        }
                        float* lp = LF + (size_t)row * 1024 + (col - 1024);
                        *(f32x4*)lp = (f32x4){lf[0], lf[1], lf[2], lf[3]}; *(f32x4*)(lp + 4) = (f32x4){lf[4], lf[5], lf[6], lf[7]};
                    }
                    u32x4 w; w.x = pk2(v[0], v[1]); w.y = pk2(v[2], v[3]); w.z = pk2(v[4], v[5]); w.w = pk2(v[6], v[7]);
                    *(u32x4*)(U + (size_t)row * INW + col) = w;
                }
        }
    }
    __device__ __forceinline__ void operator()(const f32x4 (&acc)[2][2][4][2], const pg8::Unit& u, int wr, int wc, int fr, int fq) const {
        const int seg = u.pn >> 2;
        if (seg == 0 || seg == 3) body<0>(acc, u, wr, wc, fr, fq);
        else if (seg == 1) body<1>(acc, u, wr, wc, fr, fq);
        else body<2>(acc, u, wr, wc, fr, fq);
    }
};
struct EpiRes {
    bf16_t* XB; unsigned long long* ssq; float* outp;
    __device__ __forceinline__ void operator()(const f32x4 (&acc)[2][2][4][2], const pg8::Unit& u, int wr, int wc, int fr, int fq) const {
        const int row0 = u.pm * 256 + wr * 64 + fr, colb = u.pn * 256 + wc * 32 + 8 * fq;
#pragma unroll
        for (int ai = 0; ai < 2; ++ai)
#pragma unroll
            for (int m = 0; m < 4; ++m) {
                const int row = row0 + ai * 128 + m * 16;
                float s = 0.f;
#pragma unroll
                for (int bj = 0; bj < 2; ++bj) {
                    const int col = colb + bj * 128;
                    bf16_t* xp = XB + (size_t)row * DM + col;
                    const u32x4 w0 = *(const u32x4*)xp;
                    const f32x4 x0 = (f32x4){bf2f(w0.x & 0xffffu), bf2f(w0.x >> 16), bf2f(w0.y & 0xffffu), bf2f(w0.y >> 16)} + acc[ai][bj][m][0];
                    const f32x4 x1 = (f32x4){bf2f(w0.z & 0xffffu), bf2f(w0.z >> 16), bf2f(w0.w & 0xffffu), bf2f(w0.w >> 16)} + acc[ai][bj][m][1];
                    if (outp) {
                        if (row < MR) { float* op = outp + (size_t)row * DM + col; *(f32x4*)op = x0; *(f32x4*)(op + 4) = x1; }
                    } else {
                        u32x4 w; w.x = pk2(x0[0], x0[1]); w.y = pk2(x0[2], x0[3]); w.z = pk2(x1[0], x1[1]); w.w = pk2(x1[2], x1[3]);
                        *(u32x4*)xp = w;
                        s += (x0[0] * x0[0] + x0[1] * x0[1]) + (x0[2] * x0[2] + x0[3] * x0[3]) + (x1[0] * x1[0] + x1[1] * x1[1]) + (x1[2] * x1[2] + x1[3] * x1[3]);
                    }
                }
                if (!outp) {
                    s += __shfl_xor(s, 16); s += __shfl_xor(s, 32);
                    if (fq == 0) atomicAdd(ssq + row, (unsigned long long)(s * SSQ_SCALE));
                }
            }
    }
};
struct EpiGU {
    bf16_t* ACT; const unsigned long long* ssq;
    __device__ __forceinline__ void operator()(const f32x4 (&acc)[2][2][4][2], const pg8::Unit& u, int wr, int wc, int fr, int fq) const {
        const int row0 = u.pm * 256 + wr * 64 + fr, col = u.pn * 128 + wc * 32 + 8 * fq;
#pragma unroll
        for (int ai = 0; ai < 2; ++ai)
#pragma unroll
            for (int m = 0; m < 4; ++m) {
                const int row = row0 + ai * 128 + m * 16;
                const float rstd = rsqrtf((float)ssq[row] * (SSQ_INV / DM) + EPS);
                float v[8];
#pragma unroll
                for (int e = 0; e < 8; ++e) v[e] = silu_f(acc[ai][0][m][e >> 2][e & 3] * rstd) * (acc[ai][1][m][e >> 2][e & 3] * rstd);
                u32x4 w; w.x = pk2(v[0], v[1]); w.y = pk2(v[2], v[3]); w.z = pk2(v[4], v[5]); w.w = pk2(v[6], v[7]);
                *(u32x4*)(ACT + (size_t)row * FFW + col) = w;
            }
    }
};

struct EpiNull {
    float* sink;
    __device__ __forceinline__ void operator()(const f32x4 (&acc)[2][2][4][2], const pg8::Unit& u, int wr, int wc, int fr, int fq) const {
        float t = 0.f;
#pragma unroll
        for (int ai = 0; ai < 2; ++ai)
#pragma unroll
            for (int bj = 0; bj < 2; ++bj)
#pragma unroll
                for (int m = 0; m < 4; ++m)
#pragma unroll
                    for (int n = 0; n < 2; ++n) t += acc[ai][bj][m][n][0] + acc[ai][bj][m][n][1] + acc[ai][bj][m][n][2] + acc[ai][bj][m][n][3];
        if (t == 1.2345e30f) sink[0] = t;
    }
};
struct CvtItem { const float* W; const float* g; bf16_t* WT; int K, N, k0, n0, r0; };
__device__ __forceinline__ void cvt_decode(const Params& p, int l, int it, CvtItem& c) {
    constexpr int I_IN = 32 * 176, I_OUT = 32 * 64, I_G = 32 * 176;
    unsigned char* wl = p.ws + WS_W + (size_t)l * W_LAYER;
    int r = it, gu = 0, up = 0;
    if (r < I_IN) { c.W = p.w_in + (size_t)l * DM * INW; c.g = p.norm_mix + l * DM; c.WT = (bf16_t*)(wl + W_IN_OFF); c.K = DM; c.N = INW; }
    else if ((r -= I_IN) < I_OUT) { c.W = p.w_out + (size_t)l * DM * DM; c.g = nullptr; c.WT = (bf16_t*)(wl + W_OUT_OFF); c.K = DM; c.N = DM; }
    else if ((r -= I_OUT) < I_G) { c.W = p.w_gate + (size_t)l * DM * FFW; c.g = p.norm_ffn + l * DM; c.WT = (bf16_t*)(wl + W_GU_OFF); c.K = DM; c.N = FFW; gu = 1; }
    else if ((r -= I_G) < I_G) { c.W = p.w_up + (size_t)l * DM * FFW; c.g = p.norm_ffn + l * DM; c.WT = (bf16_t*)(wl + W_GU_OFF); c.K = DM; c.N = FFW; gu = 1; up = 1; }
    else { r -= I_G; c.W = p.w_down + (size_t)l * FFW * DM; c.g = nullptr; c.WT = (bf16_t*)(wl + W_DN_OFF); c.K = FFW; c.N = DM; }
    const int nblk = c.N / 32, kb = r / nblk, nb = r % nblk;
    c.k0 = 64 * kb; c.n0 = 32 * nb;
    c.r0 = gu ? ((c.n0 >> 7) * 256 + (c.n0 & 127) + (up ? 128 : 0)) : c.n0;
}
__device__ __forceinline__ void cvt_load(const CvtItem& c, int lane, float (&wv)[32], f32x4 (&gl)[2]) {
    if (c.g) { gl[0] = *(const f32x4*)(c.g + c.k0 + 8 * (lane & 7)); gl[1] = *(const f32x4*)(c.g + c.k0 + 8 * (lane & 7) + 4); }
    else { gl[0] = (f32x4){1.f, 1.f, 1.f, 1.f}; gl[1] = gl[0]; }
#pragma unroll
    for (int i = 0; i < 32; ++i) wv[i] = __builtin_nontemporal_load(&c.W[(size_t)(c.k0 + 2 * i + (lane >> 5)) * c.N + c.n0 + (lane & 31)]);
}
__device__ __forceinline__ void cvt_store(const CvtItem& c, int lane, const float (&wv)[32], const f32x4 (&gl)[2], LAS float* scr) {
#pragma unroll
    for (int i = 0; i < 32; ++i) { const int kk = 2 * i + (lane >> 5); scr[kk * 33 + (lane & 31)] = wv[i]; }
    asm volatile("s_waitcnt lgkmcnt(0)" ::: "memory");
    const int cc = lane & 7;
#pragma unroll
    for (int j = 0; j < 4; ++j) { const int n = (lane >> 3) + 8 * j; const LAS float* sp = scr + (8 * cc) * 33 + n;
        u32x4 o; o.x = pk2(sp[0 * 33] * gl[0][0], sp[1 * 33] * gl[0][1]); o.y = pk2(sp[2 * 33] * gl[0][2], sp[3 * 33] * gl[0][3]);
        o.z = pk2(sp[4 * 33] * gl[1][0], sp[5 * 33] * gl[1][1]); o.w = pk2(sp[6 * 33] * gl[1][2], sp[7 * 33] * gl[1][3]);
        *(u32x4*)(c.WT + (size_t)(c.r0 + n) * c.K + c.k0 + 8 * cc) = o; }
    asm volatile("s_waitcnt lgkmcnt(0)" ::: "memory");
}
__device__ __forceinline__ void convert_weights(const Params& p, LAS unsigned char* lds, int l, int gw, int NGW, int it_lo, int it_hi) {
    const int tid = tid_opaque(), lane = tid & 63, wave = tid >> 6;
    LAS float* scr = (LAS float*)(lds + wave * 16384);
    constexpr int I_L = 32 * 176 * 3 + 32 * 64 + 88 * 64;
    asm volatile("" : "+s"(gw), "+s"(NGW));
    (void)I_L;
    if (it_lo + gw >= it_hi) return;
    CvtItem cur, nxt; float wv[32], wn[32]; f32x4 gl[2], gn_[2];
    cvt_decode(p, l, it_lo + gw, cur); cvt_load(cur, lane, wv, gl);
    for (int it = it_lo + gw; it < it_hi; it += NGW) {
        const bool more = it + NGW < it_hi;
        if (more) { cvt_decode(p, l, it + NGW, nxt); cvt_load(nxt, lane, wn, gn_); }
        cvt_store(cur, lane, wv, gl, scr);
        if (more) { cur = nxt; gl[0] = gn_[0]; gl[1] = gn_[1];
#pragma unroll
            for (int i = 0; i < 32; ++i) wv[i] = wn[i]; }
    }
}

__device__ __forceinline__ void prologue(const Params& p, LAS unsigned char* lds) {
    const int tid = tid_opaque(), lane = tid & 63, wave = tid >> 6, G = gridDim.x;
    const int gw = blockIdx.x * 8 + wave, NGW = G * 8;
    const int gt = blockIdx.x * 512 + tid, NGT = G * 512;
    unsigned char* ws = p.ws;
    if (gt < 1024) {
        float v[4], mx = -3.4e38f;
        for (int l = 0; l < 4; ++l) { v[l] = p.lower_bounds[l * 1024 + gt]; mx = fmaxf(mx, v[l]); }
        float s = 0.f; for (int l = 0; l < 4; ++l) { v[l] = expf(v[l] - mx); s += v[l]; }
        float* lb = (float*)(ws + WS_LB); float cum = 0.f;
        for (int l = 0; l < 4; ++l) { const float pl = v[l] / s; cum += pl; lb[l * 1024 + gt] = (l == 0) ? 0.f : cum - v[0] / s; }
    }
    { unsigned long long* ssq = (unsigned long long*)(ws + WS_SSQ); for (int i = gt; i < 8 * MP; i += NGT) ssq[MP + i] = 0ull; }
    {
        float* X = (float*)(ws + WS_X); bf16_t* XB = (bf16_t*)(ws + WS_XB); unsigned long long* ssq = (unsigned long long*)(ws + WS_SSQ); bf16_t* MIX = (bf16_t*)(ws + WS_MIX);
        for (int r = gw; r < MP; r += NGW) {
            const float* src = r < NPROMPT ? p.x_prompt + (size_t)r * DM : (r < MR ? p.x_sample + (size_t)(r - NPROMPT) * DM : nullptr);
            float s = 0.f;
#pragma unroll
            for (int j = 0; j < 8; ++j) {
                const int cidx = (j * 64 + lane) * 4;
                f32x4 v = src ? *(const f32x4*)(src + cidx) : (f32x4){0.f, 0.f, 0.f, 0.f};
                u32x2 w; w.x = pk2(v[0], v[1]); w.y = pk2(v[2], v[3]);
                *(u32x2*)(XB + (size_t)r * DM + cidx) = w;
                s += (v[0] * v[0] + v[1] * v[1]) + (v[2] * v[2] + v[3] * v[3]);
                if (r >= MR) *(u32x2*)(MIX + (size_t)r * DM + cidx) = (u32x2){0u, 0u};
            }
            s = wave_sum(s);
            if (lane == 0) ssq[r] = (unsigned long long)(s * SSQ_SCALE);
        }
    }
    convert_weights(p, lds, 0, __builtin_amdgcn_readfirstlane(gw), NGW, 0, CVT_SPLIT);
}

#define LBAR() asm volatile("s_waitcnt lgkmcnt(0)\n\ts_barrier" ::: "memory")
#define MFMA16(a, b, c) __builtin_amdgcn_mfma_f32_16x16x32_bf16((a), (b), (c), 0, 0, 0)
__device__ __forceinline__ bf16x8 mk8(unsigned a, unsigned b, unsigned c, unsigned d) { u32x4 w = (u32x4){a, b, c, d}; return __builtin_bit_cast(bf16x8, w); }
__device__ __forceinline__ bf16x8 ld8x2(const LAS bf16_t* p0, const LAS bf16_t* p1) { u32x2 a = *(const LAS u32x2*)p0, b = *(const LAS u32x2*)p1; return mk8(a.x, a.y, b.x, b.y); }

constexpr size_t PREP_ITEM_BYTES = 90112, PREP_S_OFF = 49152;
__device__ __forceinline__ void prep_item(const Params& p, int l, int it, LAS unsigned char* lds) {
    const int tid = tid_opaque(), lane = tid & 63, wid = __builtin_amdgcn_readfirstlane(tid >> 6), l15 = lane & 15, quad = lane >> 4;
    const int c = tid & 127, tq = tid >> 7;
    const int n = it & 31, h = (it >> 5) & 7, b = it >> 8;
    LAS bf16_t* QT = (LAS bf16_t*)(lds + 0); LAS bf16_t* KT = (LAS bf16_t*)(lds + 17408); LAS bf16_t* QH = (LAS bf16_t*)(lds + 34816);
    LAS bf16_t* KHt = (LAS bf16_t*)(lds + 52224); LAS bf16_t* Vt = (LAS bf16_t*)(lds + 70656);
    LAS float* TOT = (LAS float*)(lds + 123904); LAS float* DEC = (LAS float*)(lds + 125952);
    const bf16_t* U = (const bf16_t*)(p.ws + WS_U); const float* LF = (const float*)(p.ws + WS_LF);
    unsigned char* sb = p.ws + WS_ACT + (size_t)it * PREP_ITEM_BYTES;
    float lf[16]; unsigned short qr[16], kr[16], vr[16];
    {
        const size_t r0 = (size_t)b * SEQ + n * 64 + tq * 16;
#pragma unroll
        for (int i = 0; i < 16; ++i) { lf[i] = __builtin_nontemporal_load(&LF[(r0 + i) * 1024 + h * 128 + c]); const bf16_t* up = U + (r0 + i) * INW + h * 128 + c; qr[i] = __builtin_nontemporal_load(up); kr[i] = __builtin_nontemporal_load(up + 1024); vr[i] = __builtin_nontemporal_load(up + 2048); }
    }
    float cs[16]; float run = 0.f;
#pragma unroll
    for (int i = 0; i < 16; ++i) { run += lf[i]; cs[i] = run; }
    TOT[tq * 128 + c] = run;
    {
        u32x4 w0, w1;
        w0.x = (unsigned)vr[0] | ((unsigned)vr[1] << 16); w0.y = (unsigned)vr[2] | ((unsigned)vr[3] << 16); w0.z = (unsigned)vr[4] | ((unsigned)vr[5] << 16); w0.w = (unsigned)vr[6] | ((unsigned)vr[7] << 16);
        w1.x = (unsigned)vr[8] | ((unsigned)vr[9] << 16); w1.y = (unsigned)vr[10] | ((unsigned)vr[11] << 16); w1.z = (unsigned)vr[12] | ((unsigned)vr[13] << 16); w1.w = (unsigned)vr[14] | ((unsigned)vr[15] << 16);
        *(LAS u32x4*)(Vt + c * 72 + tq * 16) = w0; *(LAS u32x4*)(Vt + c * 72 + tq * 16 + 8) = w1;
    }
    LBAR();
    {
        float pre = 0.f;
        const float t0 = TOT[c], t1 = TOT[128 + c], t2 = TOT[256 + c], t3 = TOT[384 + c];
        if (tq >= 1) pre += t0; if (tq >= 2) pre += t1; if (tq >= 3) pre += t2;
        const float bmid = t0 + t1, blast = (t0 + t1) + (t2 + t3);
        unsigned kh[8];
#pragma unroll
        for (int i = 0; i < 16; i += 2) {
            const float b0 = pre + cs[i], b1 = pre + cs[i + 1];
            const float q0 = bf2f(qr[i]), q1 = bf2f(qr[i + 1]), k0 = bf2f(kr[i]), k1 = bf2f(kr[i + 1]);
            const int tt = tq * 16 + i;
            QT[tt * 136 + c] = (bf16_t)(pk2(q0 * __expf(b0 - bmid), 0.f) & 0xffffu);       QT[(tt + 1) * 136 + c] = (bf16_t)(pk2(q1 * __expf(b1 - bmid), 0.f) & 0xffffu);
            KT[tt * 136 + c] = (bf16_t)(pk2(k0 * __expf(bmid - b0), 0.f) & 0xffffu);       KT[(tt + 1) * 136 + c] = (bf16_t)(pk2(k1 * __expf(bmid - b1), 0.f) & 0xffffu);
            QH[tt * 136 + c] = (bf16_t)(pk2(q0 * __expf(b0), 0.f) & 0xffffu);              QH[(tt + 1) * 136 + c] = (bf16_t)(pk2(q1 * __expf(b1), 0.f) & 0xffffu);
            kh[i >> 1] = pk2(k0 * __expf(blast - b0), k1 * __expf(blast - b1));
        }
        *(LAS u32x4*)(KHt + c * 72 + tq * 16) = (u32x4){kh[0], kh[1], kh[2], kh[3]}; *(LAS u32x4*)(KHt + c * 72 + tq * 16 + 8) = (u32x4){kh[4], kh[5], kh[6], kh[7]};
        if (tq == 0) DEC[c] = __expf(blast);
    }
    LBAR();
    {
        const int mt = wid & 3, dh = wid >> 2;
        f32x4 aa[4];
#pragma unroll
        for (int st = 0; st < 4; ++st) aa[st] = (f32x4){0.f, 0.f, 0.f, 0.f};
        bf16x8 qfr[4];
#pragma unroll
        for (int kk = 0; kk < 4; ++kk) qfr[kk] = *(const LAS bf16x8*)(QT + (16 * mt + l15) * 136 + 32 * kk + 8 * quad);
#pragma unroll
        for (int st = 0; st < 4; ++st) if (st <= mt) {
#pragma unroll
            for (int kk = 0; kk < 4; ++kk) aa[st] = MFMA16(*(const LAS bf16x8*)(KT + (16 * st + l15) * 136 + 32 * kk + 8 * quad), qfr[kk], aa[st]);
            if (st == mt) {
#pragma unroll
                for (int j = 0; j < 4; ++j) if (4 * quad + j > l15) aa[st][j] = 0.f;
            }
        }
        bf16x8 pf[2];
        pf[0] = mk8(pk2(aa[0][0], aa[0][1]), pk2(aa[0][2], aa[0][3]), pk2(aa[1][0], aa[1][1]), pk2(aa[1][2], aa[1][3]));
        pf[1] = mk8(pk2(aa[2][0], aa[2][1]), pk2(aa[2][2], aa[2][3]), pk2(aa[3][0], aa[3][1]), pk2(aa[3][2], aa[3][3]));
        u32x2* OI = (u32x2*)sb;
#pragma unroll
        for (int n4 = 0; n4 < 4; ++n4) {
            const int nt = dh * 4 + n4;
            f32x4 o = (f32x4){0.f, 0.f, 0.f, 0.f};
            const LAS bf16_t* vrow = Vt + (16 * nt + l15) * 72 + 4 * quad;
            o = MFMA16(ld8x2(vrow, vrow + 16), pf[0], o);
            if (mt >= 2) o = MFMA16(ld8x2(vrow + 32, vrow + 48), pf[1], o);
            OI[(mt * 8 + nt) * 64 + lane] = (u32x2){pk2(o[0], o[1]), pk2(o[2], o[3])};
        }
        bf16x8* QHF = (bf16x8*)(sb + 32768);
        if (dh == 0) {
#pragma unroll
            for (int kk = 0; kk < 4; ++kk) QHF[(mt * 4 + kk) * 64 + lane] = *(const LAS bf16x8*)(QH + (16 * mt + l15) * 136 + 32 * kk + 8 * quad);
        }
        bf16x8* KHF = (bf16x8*)(sb + PREP_S_OFF); bf16x8* VF = (bf16x8*)(sb + PREP_S_OFF + 16384); float* DCG = (float*)(sb + PREP_S_OFF + 32768);
#pragma unroll
        for (int ks = 0; ks < 2; ++ks) {
            KHF[(wid * 2 + ks) * 64 + lane] = *(const LAS bf16x8*)(KHt + (16 * wid + l15) * 72 + 32 * ks + 8 * quad);
            VF[(wid * 2 + ks) * 64 + lane] = *(const LAS bf16x8*)(Vt + (16 * wid + l15) * 72 + 32 * ks + 8 * quad);
        }
        if (tid < 128) DCG[tid] = DEC[tid];
    }
    LBAR();
}

__device__ __forceinline__ void scan2_item(const Params& p, int l, int b, int h, LAS unsigned char* lds) {
    const int tid = tid_opaque(), lane = tid & 63, wid = __builtin_amdgcn_readfirstlane(tid >> 6), l15 = lane & 15, quad = lane >> 4;
    LAS bf16_t* St = (LAS bf16_t*)(lds + 98304); LAS float* GNL = (LAS float*)(lds + 133120); LAS float* SSX = (LAS float*)(lds + 133632); LAS float* DECL = (LAS float*)(lds + 134144);
    const bf16_t* U = (const bf16_t*)(p.ws + WS_U); bf16_t* MIX = (bf16_t*)(p.ws + WS_MIX);
    const unsigned char* sb0 = p.ws + WS_ACT + (size_t)((b * 8 + h) * 32) * PREP_ITEM_BYTES;
    if (tid < 128) GNL[tid] = p.hgrn_norm[l * 128 + tid];
    for (int i = tid; i < 34816 / 4; i += 512) ((LAS unsigned*)St)[i] = 0u;
    f32x4 sacc[8];
#pragma unroll
    for (int a = 0; a < 8; ++a) sacc[a] = (f32x4){0.f, 0.f, 0.f, 0.f};
    const int mt = wid & 3, dh = wid >> 2;
#define S2_DMA(n_) do { const unsigned char* g_ = sb0 + (size_t)(n_) * PREP_ITEM_BYTES + PREP_S_OFF; const unsigned sl_ = (unsigned)((n_) % 3); \
        _Pragma("unroll") for (int f = 0; f < 4; ++f) __builtin_amdgcn_global_load_lds((const unsigned*)(g_ + ((wid * 4 + f) * 64 + lane) * 16), (LAS unsigned*)(lds + sl_ * 32768u + (wid * 4 + f) * 1024), 16, 0, 0); \
        __builtin_amdgcn_global_load_lds((const unsigned*)(g_ + 32768 + lane * 16), (LAS unsigned*)(lds + 134144 + sl_ * 1024u), 16, 0, 0); } while (0)
#define S2_OLOAD(n_, OI_, QF_, GW_) do { const unsigned char* g_ = sb0 + (size_t)(n_) * PREP_ITEM_BYTES; \
        _Pragma("unroll") for (int n4 = 0; n4 < 4; ++n4) OI_[n4] = ((const u32x2*)g_)[(mt * 8 + dh * 4 + n4) * 64 + lane]; \
        _Pragma("unroll") for (int kk = 0; kk < 4; ++kk) QF_[kk] = ((const bf16x8*)(g_ + 32768))[(mt * 4 + kk) * 64 + lane]; \
        const size_t rw_ = (size_t)b * SEQ + (n_) * 64 + 16 * mt + l15; \
        _Pragma("unroll") for (int n4 = 0; n4 < 4; ++n4) GW_[n4] = *(const u32x2*)(U + rw_ * INW + 3072 + h * 128 + 16 * (dh * 4 + n4) + 4 * quad); } while (0)
    u32x2 oiX[4], oiY[4], oiA[4]; bf16x8 qfX[4], qfY[4], qfA[4]; u32x2 gwX[4], gwY[4], gwA[4];
    S2_DMA(0); S2_DMA(1); S2_OLOAD(0, oiX, qfX, gwX); S2_OLOAD(1, oiY, qfY, gwY);
    asm volatile("s_waitcnt vmcnt(0)" ::: "memory");
    LBAR();
#define S2_BODY(n_, OIT, QFT, GWT) do { \
        _Pragma("unroll") for (int n4 = 0; n4 < 4; ++n4) { oiA[n4] = OIT[n4]; gwA[n4] = GWT[n4]; } \
        _Pragma("unroll") for (int kk = 0; kk < 4; ++kk) qfA[kk] = QFT[kk]; \
        if ((n_) + 2 < 32) { S2_DMA((n_) + 2); S2_OLOAD((n_) + 2, OIT, QFT, GWT); } \
        const int slot_ = (n_) % 3; \
        f32x4 oo[4]; float ss = 0.f; \
        _Pragma("unroll") for (int h2 = 0; h2 < 2; ++h2) { \
            bf16x8 sf[2][4]; \
            _Pragma("unroll") for (int t2 = 0; t2 < 2; ++t2) _Pragma("unroll") for (int kk = 0; kk < 4; ++kk) sf[t2][kk] = *(const LAS bf16x8*)(St + (16 * (dh * 4 + 2 * h2 + t2) + l15) * 136 + 32 * kk + 8 * quad); \
            __builtin_amdgcn_sched_barrier(0); \
            _Pragma("unroll") for (int t2 = 0; t2 < 2; ++t2) { \
                const u32x2 ow = oiA[2 * h2 + t2]; \
                f32x4 o = (f32x4){bf2f(ow.x & 0xffffu), bf2f(ow.x >> 16), bf2f(ow.y & 0xffffu), bf2f(ow.y >> 16)}; \
                _Pragma("unroll") for (int kk = 0; kk < 4; ++kk) o = MFMA16(sf[t2][kk], qfA[kk], o); \
                oo[2 * h2 + t2] = o; ss += (o[0] * o[0] + o[1] * o[1]) + (o[2] * o[2] + o[3] * o[3]); } } \
        ss += __shfl_xor(ss, 16); ss += __shfl_xor(ss, 32); \
        if (quad == 0) SSX[dh * 64 + 16 * mt + l15] = ss; \
        { const LAS unsigned char* sbuf = lds + slot_ * 32768; const LAS float* dcl = DECL + slot_ * 256; \
          const bf16x8 vf0 = *(const LAS bf16x8*)(sbuf + 16384 + ((wid * 2 + 0) * 64 + lane) * 16), vf1 = *(const LAS bf16x8*)(sbuf + 16384 + ((wid * 2 + 1) * 64 + lane) * 16); \
          _Pragma("unroll") for (int h2 = 0; h2 < 2; ++h2) { \
              f32x4 dc[4]; bf16x8 kf0[4], kf1[4]; \
              _Pragma("unroll") for (int d4 = 0; d4 < 4; ++d4) { const int dkt = 4 * h2 + d4; dc[d4] = *(const LAS f32x4*)(dcl + 16 * dkt + 4 * quad); \
                  kf0[d4] = *(const LAS bf16x8*)(sbuf + ((dkt * 2 + 0) * 64 + lane) * 16); kf1[d4] = *(const LAS bf16x8*)(sbuf + ((dkt * 2 + 1) * 64 + lane) * 16); } \
              __builtin_amdgcn_sched_barrier(0); \
              _Pragma("unroll") for (int d4 = 0; d4 < 4; ++d4) { const int dkt = 4 * h2 + d4; f32x4 sv = sacc[dkt] * dc[d4]; sv = MFMA16(kf0[d4], vf0, sv); sv = MFMA16(kf1[d4], vf1, sv); sacc[dkt] = sv; } } } \
        LBAR(); \
        _Pragma("unroll") for (int dkt = 0; dkt < 8; ++dkt) { const f32x4 sv = sacc[dkt]; \
            *(LAS u32x2*)(St + (16 * wid + l15) * 136 + 16 * dkt + 4 * quad) = (u32x2){pk2(sv[0], sv[1]), pk2(sv[2], sv[3])}; } \
        { const float sst = SSX[16 * mt + l15] + SSX[64 + 16 * mt + l15]; const float rstd = rsqrtf(sst * (1.f / 128.f) + EPS); \
          const size_t r = (size_t)b * SEQ + (n_) * 64 + 16 * mt + l15; \
          _Pragma("unroll") for (int n4 = 0; n4 < 4; ++n4) { const int dv0 = 16 * (dh * 4 + n4) + 4 * quad; const u32x2 gw = gwA[n4]; const f32x4 gv = *(const LAS f32x4*)(GNL + dv0); \
              const float o0 = oo[n4][0] * rstd * gv[0] * bf2f(gw.x & 0xffffu), o1 = oo[n4][1] * rstd * gv[1] * bf2f(gw.x >> 16); \
              const float o2 = oo[n4][2] * rstd * gv[2] * bf2f(gw.y & 0xffffu), o3 = oo[n4][3] * rstd * gv[3] * bf2f(gw.y >> 16); \
              *(u32x2*)(MIX + r * DM + h * 128 + dv0) = (u32x2){pk2(o0, o1), pk2(o2, o3)}; } } \
          \
        if ((n_) + 2 < 32) asm volatile("s_waitcnt vmcnt(25)" ::: "memory"); else asm volatile("s_waitcnt vmcnt(4)" ::: "memory"); \
        LBAR(); } while (0)
    for (int n = 0; n < 32; n += 2) {
        S2_BODY(n, oiX, qfX, gwX);
        S2_BODY(n + 1, oiY, qfY, gwY);
    }
#undef S2_BODY
#undef S2_DMA
#undef S2_OLOAD
    {
        float* ps = p.out + O_PS + ((size_t)(l * 4 + b) * 8 + h) * 16384;
#pragma unroll
        for (int dkt = 0; dkt < 8; ++dkt)
#pragma unroll
            for (int j = 0; j < 4; ++j) ps[(16 * dkt + 4 * quad + j) * 128 + 16 * wid + l15] = sacc[dkt][j];
    }
    __syncthreads();
}

__device__ __forceinline__ void attn_item(const Params& p, int l, int b, int blk, int hk, LAS unsigned char* lds) {
    const int tid = tid_opaque(), lane = tid & 63, wid = __builtin_amdgcn_readfirstlane(tid >> 6), l15 = lane & 15, quad = lane >> 4;
    LAS bf16_t* Kn = (LAS bf16_t*)(lds + 0); LAS bf16_t* Vt = (LAS bf16_t*)(lds + 36864); LAS float* BT = (LAS float*)(lds + 70656);
    const bf16_t* U = (const bf16_t*)(p.ws + WS_U); bf16_t* MIX = (bf16_t*)(p.ws + WS_MIX);
    {
        const int j = tid >> 1, half = tid & 1;
        const bool live = (blk > 0) || (j >= 128);
        const size_t r = (size_t)b * SEQ + blk * 128 - 128 + j;
        float kv[32]; unsigned vw[16];
        if (live) {
            const bf16_t* kp = U + r * INW + 5120 + hk * 64 + half * 32; const bf16_t* vp = kp + 256;
#pragma unroll
            for (int q4 = 0; q4 < 4; ++q4) {
                const u32x4 w = *(const u32x4*)(kp + 8 * q4);
                kv[8 * q4 + 0] = bf2f(w.x & 0xffffu); kv[8 * q4 + 1] = bf2f(w.x >> 16); kv[8 * q4 + 2] = bf2f(w.y & 0xffffu); kv[8 * q4 + 3] = bf2f(w.y >> 16);
                kv[8 * q4 + 4] = bf2f(w.z & 0xffffu); kv[8 * q4 + 5] = bf2f(w.z >> 16); kv[8 * q4 + 6] = bf2f(w.w & 0xffffu); kv[8 * q4 + 7] = bf2f(w.w >> 16);
                const u32x4 x = *(const u32x4*)(vp + 8 * q4);
                vw[4 * q4 + 0] = x.x; vw[4 * q4 + 1] = x.y; vw[4 * q4 + 2] = x.z; vw[4 * q4 + 3] = x.w;
            }
        } else {
#pragma unroll
            for (int e = 0; e < 32; ++e) kv[e] = 0.f;
#pragma unroll
            for (int e = 0; e < 16; ++e) vw[e] = 0u;
        }
        float s = 0.f;
#pragma unroll
        for (int e = 0; e < 32; ++e) s += kv[e] * kv[e];
        s += __shfl_xor(s, 1);
        const float rstd = rsqrtf(s * (1.f / 64.f) + EPS);
        const float* kg = p.k_norm + l * 64 + half * 32;
#pragma unroll
        for (int e = 0; e < 32; ++e) kv[e] = kv[e] * rstd * kg[e];
#pragma unroll
        for (int q4 = 0; q4 < 4; ++q4)
            *(LAS u32x4*)(Kn + j * 72 + half * 32 + 8 * q4) = (u32x4){pk2(kv[8 * q4], kv[8 * q4 + 1]), pk2(kv[8 * q4 + 2], kv[8 * q4 + 3]), pk2(kv[8 * q4 + 4], kv[8 * q4 + 5]), pk2(kv[8 * q4 + 6], kv[8 * q4 + 7])};
#pragma unroll
        for (int e = 0; e < 16; ++e) { Vt[(half * 32 + 2 * e) * 264 + j] = (bf16_t)(vw[e] & 0xffffu); Vt[(half * 32 + 2 * e + 1) * 264 + j] = (bf16_t)(vw[e] >> 16); }
        if (blk == 15 && j >= 128) {
            float* pk = p.out + O_PK + ((((size_t)l * 4 + b) * 128 + (j - 128)) * 4 + hk) * 64 + half * 32;
            float* pv = p.out + O_PV + ((((size_t)l * 4 + b) * 128 + (j - 128)) * 4 + hk) * 64 + half * 32;
#pragma unroll
            for (int q4 = 0; q4 < 8; ++q4) {
                *(f32x4*)(pk + 4 * q4) = (f32x4){kv[4 * q4], kv[4 * q4 + 1], kv[4 * q4 + 2], kv[4 * q4 + 3]};
                *(f32x4*)(pv + 4 * q4) = (f32x4){bf2f(vw[2 * q4] & 0xffffu), bf2f(vw[2 * q4] >> 16), bf2f(vw[2 * q4 + 1] & 0xffffu), bf2f(vw[2 * q4 + 1] >> 16)};
            }
        }
        BT[tid] = p.rel_bias[t5_bucket(tid & 127) * 16 + hk * 4 + (tid >> 7)];
    }
    __syncthreads();
    const int g = wid >> 1, hq = hk * 4 + g;
    const float sink = p.sinks[l * 16 + hq];
    const float* qg = p.q_norm + l * 64;
    for (int task = 0; task < 2; ++task) {
        const int rg = 2 * (wid & 1) + task;
        bf16x8 qf[2][2];
#pragma unroll
        for (int qt = 0; qt < 2; ++qt) {
            const size_t r = (size_t)b * SEQ + blk * 128 + 32 * rg + 16 * qt + l15;
            float x[2][8]; float s = 0.f;
#pragma unroll
            for (int kk = 0; kk < 2; ++kk) {
                const u32x4 w = *(const u32x4*)(U + r * INW + 4096 + hq * 64 + 32 * kk + 8 * quad);
                x[kk][0] = bf2f(w.x & 0xffffu); x[kk][1] = bf2f(w.x >> 16); x[kk][2] = bf2f(w.y & 0xffffu); x[kk][3] = bf2f(w.y >> 16);
                x[kk][4] = bf2f(w.z & 0xffffu); x[kk][5] = bf2f(w.z >> 16); x[kk][6] = bf2f(w.w & 0xffffu); x[kk][7] = bf2f(w.w >> 16);
#pragma unroll
                for (int e = 0; e < 8; ++e) s += x[kk][e] * x[kk][e];
            }
            s += __shfl_xor(s, 16); s += __shfl_xor(s, 32);
            const float rstd = rsqrtf(s * (1.f / 64.f) + EPS) * 0.125f;
#pragma unroll
            for (int kk = 0; kk < 2; ++kk) {
                const f32x4 g0 = *(const f32x4*)(qg + 32 * kk + 8 * quad), g1 = *(const f32x4*)(qg + 32 * kk + 8 * quad + 4);
                qf[qt][kk] = mk8(pk2(x[kk][0] * rstd * g0[0], x[kk][1] * rstd * g0[1]), pk2(x[kk][2] * rstd * g0[2], x[kk][3] * rstd * g0[3]),
                                 pk2(x[kk][4] * rstd * g1[0], x[kk][5] * rstd * g1[1]), pk2(x[kk][6] * rstd * g1[2], x[kk][7] * rstd * g1[3]));
            }
        }
        f32x4 sc[10][2];
#pragma unroll
        for (int kb = 0; kb < 2; ++kb) {
            bf16x8 kfr[5][2];
#pragma unroll
            for (int k5 = 0; k5 < 5; ++k5) {
                const LAS bf16_t* kp = Kn + (16 * (2 * rg + 5 * kb + k5) + l15) * 72 + 8 * quad;
                kfr[k5][0] = *(const LAS bf16x8*)kp; kfr[k5][1] = *(const LAS bf16x8*)(kp + 32);
            }
            __builtin_amdgcn_sched_barrier(0);
#pragma unroll
            for (int k5 = 0; k5 < 5; ++k5)
#pragma unroll
                for (int qt = 0; qt < 2; ++qt) { f32x4 a = (f32x4){0.f, 0.f, 0.f, 0.f}; a = MFMA16(kfr[k5][0], qf[qt][0], a); a = MFMA16(kfr[k5][1], qf[qt][1], a); sc[5 * kb + k5][qt] = a; }
        }
        float mx[2] = {-3.0e38f, -3.0e38f};
#pragma unroll
        for (int kt = 0; kt < 10; ++kt)
#pragma unroll
            for (int qt = 0; qt < 2; ++qt)
#pragma unroll
                for (int j = 0; j < 4; ++j) {
                    const int jk = 16 * (2 * rg + kt) + 4 * quad + j, qi = 32 * rg + 16 * qt + l15, dist = 128 + qi - jk;
                    const bool valid = ((unsigned)dist < 128u) && (blk > 0 || jk >= 128);
                    const float s = valid ? sc[kt][qt][j] + BT[g * 128 + (dist & 127)] : -1e30f;
                    sc[kt][qt][j] = s; mx[qt] = fmaxf(mx[qt], s);
                }
        float sm[2];
#pragma unroll
        for (int qt = 0; qt < 2; ++qt) {
            float m = mx[qt]; m = fmaxf(m, __shfl_xor(m, 16)); m = fmaxf(m, __shfl_xor(m, 32)); m = fmaxf(m, sink); mx[qt] = m;
            float s = 0.f;
#pragma unroll
            for (int kt = 0; kt < 10; ++kt)
#pragma unroll
                for (int j = 0; j < 4; ++j) { const float e = __expf(sc[kt][qt][j] - m); sc[kt][qt][j] = e; s += e; }
            s += __shfl_xor(s, 16); s += __shfl_xor(s, 32);
            sm[qt] = 1.f / (s + __expf(sink - m));
        }
        bf16x8 pf[5][2];
#pragma unroll
        for (int g5 = 0; g5 < 5; ++g5)
#pragma unroll
            for (int qt = 0; qt < 2; ++qt) {
                const f32x4 a = sc[2 * g5][qt] * sm[qt], c2 = sc[2 * g5 + 1][qt] * sm[qt];
                pf[g5][qt] = mk8(pk2(a[0], a[1]), pk2(a[2], a[3]), pk2(c2[0], c2[1]), pk2(c2[2], c2[3]));
            }
#pragma unroll
        for (int dt = 0; dt < 4; ++dt) {
            f32x4 o0 = (f32x4){0.f, 0.f, 0.f, 0.f}, o1 = (f32x4){0.f, 0.f, 0.f, 0.f};
            bf16x8 vfr[5];
#pragma unroll
            for (int g5 = 0; g5 < 5; ++g5) {
                const LAS bf16_t* vp = Vt + (16 * dt + l15) * 264 + 16 * (2 * rg + 2 * g5) + 4 * quad;
                vfr[g5] = ld8x2(vp, vp + 16);
            }
            __builtin_amdgcn_sched_barrier(0);
#pragma unroll
            for (int g5 = 0; g5 < 5; ++g5) { o0 = MFMA16(vfr[g5], pf[g5][0], o0); o1 = MFMA16(vfr[g5], pf[g5][1], o1); }
            const size_t r0 = (size_t)b * SEQ + blk * 128 + 32 * rg + l15;
            *(u32x2*)(MIX + r0 * DM + 1024 + hq * 64 + 16 * dt + 4 * quad) = (u32x2){pk2(o0[0], o0[1]), pk2(o0[2], o0[3])};
            *(u32x2*)(MIX + (r0 + 16) * DM + 1024 + hq * 64 + 16 * dt + 4 * quad) = (u32x2){pk2(o1[0], o1[1]), pk2(o1[2], o1[3])};
        }
    }
    LBAR();
}

__device__ __forceinline__ void hgrn_sample_item(const Params& p, int l, int b, int h, LAS unsigned char* lds) {
    const int tid = tid_opaque(), lane = tid & 63, wid = tid >> 6;
    const int dv4 = tid & 31, dkg = tid >> 5;
    LAS float* RED = (LAS float*)lds;
    LAS float* SSW = (LAS float*)(lds + 32768);
    const bf16_t* U = (const bf16_t*)(p.ws + WS_U); const float* LF = (const float*)(p.ws + WS_LF); bf16_t* MIX = (bf16_t*)(p.ws + WS_MIX);
    const float* s0 = p.state + (((size_t)l * 32 + b) * 8 + h) * 16384;
    float* s1 = p.out + O_SS + (((size_t)l * 32 + b) * 8 + h) * 16384;
    f32x4 S[8];
#pragma unroll
    for (int i = 0; i < 8; ++i) S[i] = __builtin_nontemporal_load((const f32x4*)(s0 + (8 * dkg + i) * 128 + 4 * dv4));
#pragma unroll
    for (int t = 0; t < 4; ++t) {
        const size_t r = NPROMPT + b * 4 + t;
        const u32x2 vw = *(const u32x2*)(U + r * INW + 2048 + h * 128 + 4 * dv4);
        const f32x4 v = (f32x4){bf2f(vw.x & 0xffffu), bf2f(vw.x >> 16), bf2f(vw.y & 0xffffu), bf2f(vw.y >> 16)};
        f32x4 o = (f32x4){0.f, 0.f, 0.f, 0.f};
#pragma unroll
        for (int i = 0; i < 8; ++i) {
            const int dk = 8 * dkg + i;
            const float f = __expf(LF[r * 1024 + h * 128 + dk]);
            const float k = bf2f(U[r * INW + 1024 + h * 128 + dk]), q = bf2f(U[r * INW + h * 128 + dk]);
            S[i] = S[i] * f + v * k;
            o += S[i] * q;
        }
        *(LAS f32x4*)(RED + (t * 16 + dkg) * 128 + 4 * dv4) = o;
    }
#pragma unroll
    for (int i = 0; i < 8; ++i) __builtin_nontemporal_store(S[i], (f32x4*)(s1 + (8 * dkg + i) * 128 + 4 * dv4));
    LBAR();
    const int t = tid >> 7, dv = tid & 127;
    float o = 0.f;
#pragma unroll
    for (int i = 0; i < 16; ++i) o += RED[(t * 16 + i) * 128 + dv];
    const float ws_ = wave_sum(o * o);
    if (lane == 0) SSW[wid] = ws_;
    LBAR();
    const float ss = SSW[2 * t] + SSW[2 * t + 1];
    const float rstd = rsqrtf(ss * (1.f / 128.f) + EPS);
    const size_t r = NPROMPT + b * 4 + t;
    const float gate = bf2f(U[r * INW + 3072 + h * 128 + dv]);
    MIX[r * DM + h * 128 + dv] = (bf16_t)(pk2(o * rstd * p.hgrn_norm[l * 128 + dv] * gate, 0.f) & 0xffffu);
    LBAR();
}

__device__ __forceinline__ void attn_sample_item(const Params& p, int l, int b, int hk, LAS unsigned char* lds) {
    const int tid = tid_opaque(), lane = tid & 63, wid = tid >> 6;
    LAS float* KS = (LAS float*)lds;
    LAS float* VS = (LAS float*)(lds + 34320);
    LAS float* QS = (LAS float*)(lds + 34320 + 33792);
    LAS float* SC = (LAS float*)(lds + 34320 + 33792 + 4160);
    const bf16_t* U = (const bf16_t*)(p.ws + WS_U); bf16_t* MIX = (bf16_t*)(p.ws + WS_MIX);
    const float* ck = p.cache_k + (((size_t)l * 32 + b) * 128) * 256 + hk * 64;
    const float* cv = p.cache_v + (((size_t)l * 32 + b) * 128) * 256 + hk * 64;
    for (int idx = tid; idx < 128 * 16; idx += 512) {
        const int j = idx >> 4, d4 = (idx & 15) * 4;
        const f32x4 a = __builtin_nontemporal_load((const f32x4*)(ck + (size_t)j * 256 + d4)), v4 = __builtin_nontemporal_load((const f32x4*)(cv + (size_t)j * 256 + d4));
        KS[j * 65 + d4] = a[0]; KS[j * 65 + d4 + 1] = a[1]; KS[j * 65 + d4 + 2] = a[2]; KS[j * 65 + d4 + 3] = a[3];
        *(LAS f32x4*)(VS + j * 64 + d4) = v4;
    }
    if (wid < 4) {
        const size_t r = NPROMPT + b * 4 + wid;
        const float x = bf2f(U[r * INW + 5120 + hk * 64 + lane]);
        const float rstd = rsqrtf(wave_sum(x * x) * (1.f / 64.f) + EPS);
        KS[(128 + wid) * 65 + lane] = x * rstd * p.k_norm[l * 64 + lane];
        VS[(128 + wid) * 64 + lane] = bf2f(U[r * INW + 5376 + hk * 64 + lane]);
    }
#pragma unroll
    for (int i = 0; i < 2; ++i) {
        const int qi = 2 * wid + i, t = qi >> 2, g = qi & 3;
        const size_t r = NPROMPT + b * 4 + t;
        const float x = bf2f(U[r * INW + 4096 + (hk * 4 + g) * 64 + lane]);
        const float rstd = rsqrtf(wave_sum(x * x) * (1.f / 64.f) + EPS);
        QS[qi * 65 + lane] = x * rstd * p.q_norm[l * 64 + lane] * 0.125f;
    }
    __syncthreads();
    {
        float* sk = p.out + O_SK + (((size_t)l * 32 + b) * 128) * 256 + hk * 64;
        float* sv = p.out + O_SV + (((size_t)l * 32 + b) * 128) * 256 + hk * 64;
        for (int idx = tid; idx < 128 * 16; idx += 512) {
            const int j = idx >> 4, d4 = (idx & 15) * 4;
            const f32x4 a = (f32x4){KS[(j + 4) * 65 + d4], KS[(j + 4) * 65 + d4 + 1], KS[(j + 4) * 65 + d4 + 2], KS[(j + 4) * 65 + d4 + 3]};
            __builtin_nontemporal_store(a, (f32x4*)(sk + (size_t)j * 256 + d4));
            __builtin_nontemporal_store(*(const LAS f32x4*)(VS + (j + 4) * 64 + d4), (f32x4*)(sv + (size_t)j * 256 + d4));
        }
    }
    for (int pi = tid; pi < 16 * 132; pi += 512) {
        const int qi = pi / 132, j = pi - qi * 132, t = qi >> 2, g = qi & 3, dist = 128 + t - j;
        float s = 0.f;
#pragma unroll 8
        for (int d = 0; d < 64; ++d) s += QS[qi * 65 + d] * KS[j * 65 + d];
        const bool valid = (unsigned)dist < 128u;
        SC[qi * 136 + j] = valid ? s + p.rel_bias[t5_bucket(dist & 127) * 16 + hk * 4 + g] : -1e30f;
    }
    __syncthreads();
#pragma unroll
    for (int i = 0; i < 2; ++i) {
        const int qi = 2 * wid + i, g = qi & 3;
        const float sink = p.sinks[l * 16 + hk * 4 + g];
        const float a0 = SC[qi * 136 + lane], a1 = SC[qi * 136 + 64 + lane], a2 = (lane < 4) ? SC[qi * 136 + 128 + lane] : -1e30f;
        const float m = fmaxf(wave_max(fmaxf(fmaxf(a0, a1), a2)), sink);
        const float e0 = __expf(a0 - m), e1 = __expf(a1 - m), e2 = (lane < 4) ? __expf(a2 - m) : 0.f;
        const float inv = 1.f / (wave_sum(e0 + e1 + e2) + __expf(sink - m));
        SC[qi * 136 + lane] = e0 * inv; SC[qi * 136 + 64 + lane] = e1 * inv; if (lane < 4) SC[qi * 136 + 128 + lane] = e2 * inv;
    }
    __syncthreads();
#pragma unroll
    for (int i = 0; i < 2; ++i) {
        const int pi = tid + 512 * i, qi = pi >> 6, d = pi & 63, t = qi >> 2, g = qi & 3;
        float o = 0.f;
        for (int j = 0; j < 132; ++j) o += SC[qi * 136 + j] * VS[j * 64 + d];
        const size_t r = NPROMPT + b * 4 + t;
        MIX[r * DM + 1024 + (hk * 4 + g) * 64 + d] = (bf16_t)(pk2(o, 0.f) & 0xffffu);
    }
    LBAR();
}

__device__ __forceinline__ void mix_other(const Params& p, int l, int j, LAS unsigned char* lds) {
    if (j < 256) { hgrn_sample_item(p, l, j >> 3, j & 7, lds); return; } j -= 256;
    attn_sample_item(p, l, j >> 2, j & 3, lds);
}
template <int K>
__device__ __forceinline__ void sample_tail(LAS unsigned char* lds, const bf16_t* A, const bf16_t* Bt, float* X, bf16_t* XB, unsigned long long* ssq, float* outp, bool dry = false, int first = -1, int stride = 0) {
    const int tid = tid_opaque(), lane = tid & 63, wid = __builtin_amdgcn_readfirstlane(tid >> 6), l15 = lane & 15, quad = lane >> 4;
    constexpr int KW = K / 8, NKS = KW / 32, NG = NKS / 2;
    LAS f32x4* RED = (LAS f32x4*)lds;
    if (first < 0) { first = blockIdx.x; stride = gridDim.x; }
    for (int piece = first; piece < 256; piece += stride) {
        const int row0 = NPROMPT + 64 * (piece & 1), col0 = 16 * (piece >> 1);
        const bf16_t* ap = A + (size_t)(row0 + l15) * K + wid * KW + 8 * quad;
        const bf16_t* bp = Bt + (size_t)(col0 + l15) * K + wid * KW + 8 * quad;
        f32x4 acc[4];
#pragma unroll
        for (int m = 0; m < 4; ++m) acc[m] = (f32x4){0.f, 0.f, 0.f, 0.f};
        bf16x8 ra[3][2][4], rb[3][2];
#define TL_LOAD(slot, g_) do { _Pragma("unroll") for (int s2 = 0; s2 < 2; ++s2) { rb[slot][s2] = *(const bf16x8*)(bp + 64 * (g_) + 32 * s2); \
            _Pragma("unroll") for (int m = 0; m < 4; ++m) ra[slot][s2][m] = *(const bf16x8*)(ap + (size_t)(16 * m) * K + 64 * (g_) + 32 * s2); } } while (0)
        TL_LOAD(0, 0); if (NG > 1) TL_LOAD(1, 1);
#pragma unroll
        for (int g = 0; g < NG; ++g) {
            if (g + 2 < NG) TL_LOAD((g + 2) % 3, g + 2);
#pragma unroll
            for (int s2 = 0; s2 < 2; ++s2)
#pragma unroll
                for (int m = 0; m < 4; ++m) acc[m] = MFMA16(rb[g % 3][s2], ra[g % 3][s2][m], acc[m]);
        }
#undef TL_LOAD
#pragma unroll
        for (int m = 0; m < 4; ++m) RED[(wid * 4 + m) * 64 + lane] = acc[m];
        __syncthreads();
        if (wid < 4) {
            f32x4 v = RED[wid * 64 + lane];
#pragma unroll
            for (int w = 1; w < 8; ++w) v += RED[(w * 4 + wid) * 64 + lane];
            const int row = row0 + 16 * wid + l15, col = col0 + 4 * quad;
            const u32x2 xw = *(const u32x2*)(XB + (size_t)row * DM + col);
            const f32x4 x = (f32x4){bf2f(xw.x & 0xffffu), bf2f(xw.x >> 16), bf2f(xw.y & 0xffffu), bf2f(xw.y >> 16)} + v;
            if (dry) { if (x[0] == 1.2345e30f) XB[0] = 1; }
            else if (outp) { *(f32x4*)(outp + (size_t)row * DM + col) = x; }
            else {
                *(u32x2*)(XB + (size_t)row * DM + col) = (u32x2){pk2(x[0], x[1]), pk2(x[2], x[3])};
                float sq = (x[0] * x[0] + x[1] * x[1]) + (x[2] * x[2] + x[3] * x[3]);
                sq += __shfl_xor(sq, 16); sq += __shfl_xor(sq, 32);
                if (quad == 0) atomicAdd(ssq + row, (unsigned long long)(sq * SSQ_SCALE));
            }
        }
        __syncthreads();
    }
}


__device__ __forceinline__ void mix_phase_a(const Params& p, int l, LAS unsigned char* lds) {
    for (int j = blockIdx.x; j < 1024; j += gridDim.x) prep_item(p, l, j, lds);
}
__device__ __forceinline__ void mix_phase_b(const Params& p, int l, LAS unsigned char* lds) {
    const int G = gridDim.x, c = blockIdx.x;
    if (G > 64) {
        if (c < 32) scan2_item(p, l, c >> 3, c & 7, lds);
        else {
            unsigned char* wl = p.ws + WS_W + (size_t)l * W_LAYER;
            unsigned* cnt = (unsigned*)(p.ws + WS_CNT) + l * 64;
            for (int j = c - 32; j < 384; j += G - 32) {
                mix_other(p, l, j, lds);
                asm volatile("s_waitcnt vmcnt(0)" ::: "memory"); __syncthreads();
                if (threadIdx.x == 0) { __builtin_amdgcn_fence(__ATOMIC_RELEASE, "agent"); asm volatile("s_waitcnt vmcnt(0)" ::: "memory");
                    __hip_atomic_fetch_add(cnt, 1u, __ATOMIC_RELAXED, __HIP_MEMORY_SCOPE_AGENT); }
            }
            for (int j = c - 32; j < 256; j += G - 32) attn_item(p, l, j >> 6, (j >> 2) & 15, j & 3, lds);
            convert_weights(p, lds, l, (c - 32) * 8 + __builtin_amdgcn_readfirstlane((int)(threadIdx.x >> 6)), (G - 32) * 8, CVT_SPLIT + CVT_QIN, CVT_ALL);
            __syncthreads();
            if (threadIdx.x == 0) {
                unsigned sp = 0; while (__hip_atomic_load(cnt, __ATOMIC_RELAXED, __HIP_MEMORY_SCOPE_AGENT) < 384u) { __builtin_amdgcn_s_sleep(2); if (++sp > (1u << 24)) break; }
            }
            __syncthreads();
            __builtin_amdgcn_fence(__ATOMIC_ACQUIRE, "agent");
            sample_tail<DM>(lds, (const bf16_t*)(p.ws + WS_MIX), (const bf16_t*)(wl + W_OUT_OFF), nullptr, (bf16_t*)(p.ws + WS_XB), (unsigned long long*)(p.ws + WS_SSQ) + (size_t)(2 * l + 1) * MP, nullptr, false, c - 32, G - 32);
        }
    } else {
        for (int j = c; j < 32; j += G) scan2_item(p, l, j >> 3, j & 7, lds);
        unsigned char* wl = p.ws + WS_W + (size_t)l * W_LAYER;
        unsigned* cnt = (unsigned*)(p.ws + WS_CNT) + l * 64;
        for (int j = c; j < 384; j += G) {
            mix_other(p, l, j, lds);
            asm volatile("s_waitcnt vmcnt(0)" ::: "memory"); __syncthreads();
            if (threadIdx.x == 0) { __builtin_amdgcn_fence(__ATOMIC_RELEASE, "agent"); asm volatile("s_waitcnt vmcnt(0)" ::: "memory");
                __hip_atomic_fetch_add(cnt, 1u, __ATOMIC_RELAXED, __HIP_MEMORY_SCOPE_AGENT); }
        }
        for (int j = c; j < 256; j += G) attn_item(p, l, j >> 6, (j >> 2) & 15, j & 3, lds);
        convert_weights(p, lds, l, c * 8 + __builtin_amdgcn_readfirstlane((int)(threadIdx.x >> 6)), G * 8, CVT_SPLIT + CVT_QIN, CVT_ALL);
        __syncthreads();
        if (threadIdx.x == 0) { unsigned sp = 0; while (__hip_atomic_load(cnt, __ATOMIC_RELAXED, __HIP_MEMORY_SCOPE_AGENT) < 384u) { __builtin_amdgcn_s_sleep(2); if (++sp > (1u << 24)) break; } }
        __syncthreads();
        __builtin_amdgcn_fence(__ATOMIC_ACQUIRE, "agent");
        sample_tail<DM>(lds, (const bf16_t*)(p.ws + WS_MIX), (const bf16_t*)(wl + W_OUT_OFF), nullptr, (bf16_t*)(p.ws + WS_XB), (unsigned long long*)(p.ws + WS_SSQ) + (size_t)(2 * l + 1) * MP, nullptr);
    }
}

#define XB_TMO      128
#define XB_XCNT(j)  (256  + 64 * (j))
#define XB_XSUB(j)  (1280 + 64 * (j))
#define XB_XGEN(j)  (2304 + 64 * (j))
#define XB_TOP      3328
#define XB_TOPGEN   3392
#define XCD_BAR_WORDS 3456
#define XB_SPIN_CAP (1u << 22)
__device__ __forceinline__ unsigned xb_ld(unsigned* p)              { return __hip_atomic_load(p, __ATOMIC_RELAXED, __HIP_MEMORY_SCOPE_AGENT); }
__device__ __forceinline__ unsigned xb_add(unsigned* p, unsigned v) { return __hip_atomic_fetch_add(p, v, __ATOMIC_RELAXED, __HIP_MEMORY_SCOPE_AGENT); }
__device__ __forceinline__ unsigned xb_xcc_id() { return (unsigned)__builtin_amdgcn_s_getreg((3 << 11) | 20) & 0xFu; }
#define XB_SPIN(cond, bar) do { unsigned _sp = 0; while (cond) { __builtin_amdgcn_s_sleep(1); \
    if ((++_sp & 255u) == 0u) { if (xb_ld(&(bar)[XB_TMO])) break; if (_sp > XB_SPIN_CAP) { atomicAdd(&(bar)[XB_TMO], 1u); break; } } } } while (0)
struct XcdBarrier { unsigned* bar; unsigned x; volatile LAS unsigned* st; };
__device__ __forceinline__ XcdBarrier xcd_barrier_post(unsigned* bar, volatile LAS unsigned* st) {
    XcdBarrier b; b.bar = bar; b.x = xb_xcc_id(); b.st = st;
    if (threadIdx.x == 0) (void)xb_add(&bar[XB_XCNT(b.x)], 1u);
    return b;
}
__device__ __forceinline__ void xcd_barrier_complete(unsigned* bar, unsigned x, unsigned& nloc, unsigned& nx) {
    const unsigned G = gridDim.x * gridDim.y * gridDim.z;
    unsigned sum, cnt, mine, sp = 0u;
    for (;;) {
        sum = 0u; cnt = 0u; mine = 0u;
#pragma unroll
        for (unsigned j = 0; j < 16; ++j) { const unsigned c = xb_ld(&bar[XB_XCNT(j)]); sum += c; cnt += (c > 0u) ? 1u : 0u; mine = (j == x) ? c : mine; }
        if (sum == G) break;
        __builtin_amdgcn_s_sleep(1);
        if ((++sp & 255u) == 0u) { if (xb_ld(&bar[XB_TMO])) break; if (sp > XB_SPIN_CAP) { atomicAdd(&bar[XB_TMO], 1u); break; } }
    }
    nloc = mine > 0u ? mine : 1u; nx = cnt > 0u ? cnt : 1u;
}
__device__ __forceinline__ void xcd_barrier(const XcdBarrier& b) {
    asm volatile("s_waitcnt vmcnt(0)" ::: "memory");
    __syncthreads();
    if (threadIdx.x == 0) {
        unsigned* bar = b.bar;
        __builtin_amdgcn_s_waitcnt(0);
        unsigned nloc = b.st[0], nx = b.st[1];
        if (nloc == 0u) { xcd_barrier_complete(bar, b.x, nloc, nx); b.st[0] = nloc; b.st[1] = nx; }
        const unsigned old = xb_add(&bar[XB_XSUB(b.x)], 1u);
        const unsigned gen = old / nloc;
        if (old + 1u == (gen + 1u) * nloc) {
            __builtin_amdgcn_fence(__ATOMIC_RELEASE, "agent");
            asm volatile("s_waitcnt vmcnt(0)" ::: "memory");
            const unsigned og = xb_add(&bar[XB_TOP], 1u);
            const unsigned tg = og / nx;
            if (og + 1u == (tg + 1u) * nx) xb_add(&bar[XB_TOPGEN], 1u);
            else XB_SPIN(xb_ld(&bar[XB_TOPGEN]) == tg, bar);
            __builtin_amdgcn_fence(__ATOMIC_ACQUIRE, "agent");
            xb_add(&bar[XB_XGEN(b.x)], 1u);
            asm volatile("s_waitcnt vmcnt(0)" ::: "memory");
        } else {
            XB_SPIN(xb_ld(&bar[XB_XGEN(b.x)]) == gen, bar);
            __builtin_amdgcn_fence(__ATOMIC_ACQUIRE, "agent");
            asm volatile("s_waitcnt vmcnt(0)" ::: "memory");
        }
    }
    __syncthreads();
}

__global__ void __launch_bounds__(512, 2) fwd_mega(Params p) {
    extern __shared__ __attribute__((aligned(16))) unsigned char lds_raw[];
    LAS unsigned char* lds = (LAS unsigned char*)lds_raw;
    cg::grid_group grid = cg::this_grid();
    unsigned char* ws = p.ws;
    const int lo = p.ph_lo, hi = p.ph_hi, G = gridDim.x;
    int ph = 0;
    unsigned* barw = (unsigned*)(ws + WS_BAR);
    volatile LAS unsigned* bst = (volatile LAS unsigned*)(lds + LDS_BYTES - 64);
    if (threadIdx.x == 0) { bst[0] = 0u; bst[1] = 0u; }
    if (blockIdx.x == 0) { for (int i = threadIdx.x; i < XCD_BAR_WORDS; i += 512) barw[i] = 0u; if (threadIdx.x < 4) ((unsigned*)(ws + WS_CNT))[threadIdx.x * 64] = 0u; }
    XcdBarrier xbar; xbar.bar = barw; xbar.x = 0; xbar.st = bst;
#define SEAM() do { if (ph >= lo && ph + 1 < hi) { if (ph == lo) { grid.sync(); xbar = xcd_barrier_post(barw, bst); } else { xcd_barrier(xbar); if (PROBE_SYNC2) xcd_barrier(xbar); } } ++ph; } while (0)
#define IN() (ph >= lo && ph < hi)
    if (IN()) { prologue(p, lds); if (PROBE_PRO2) { __syncthreads(); prologue(p, lds); } }
    SEAM();
    for (int l = 0; l < DEPTH; ++l) {
        unsigned char* wl = ws + WS_W + (size_t)l * W_LAYER;
        unsigned long long* ssq = (unsigned long long*)(ws + WS_SSQ);
        if (IN()) {
            pg8::Gemm g{(const bf16_t*)(ws + WS_XB), (const bf16_t*)(wl + W_IN_OFF), MP, INW, DM}; pg8::StaticOrder S; S.init(MP, INW, G, bid_opaque());
            EpiIn E{(bf16_t*)(ws + WS_U), (float*)(ws + WS_LF), ssq + (size_t)(2 * l) * MP, (const float*)(ws + WS_LB) + l * 1024};
            pg8::gemm_phase<EpiIn>(lds, g, S, E);
            {
                const int nfull = S.nwg % G, c = blockIdx.x;
                if (nfull != 0 && c >= nfull) convert_weights(p, lds, l, (c - nfull) * 8 + __builtin_amdgcn_readfirstlane((int)(threadIdx.x >> 6)), (G - nfull) * 8, CVT_SPLIT, CVT_SPLIT + CVT_QIN);
                else if (nfull == 0) convert_weights(p, lds, l, c * 8 + __builtin_amdgcn_readfirstlane((int)(threadIdx.x >> 6)), G * 8, CVT_SPLIT, CVT_SPLIT + CVT_QIN);
            }
            if (PROBE_IN2 == 1) { __syncthreads(); pg8::gemm_phase<EpiIn>(lds, g, S, E); }
        }
        SEAM();
        if (IN()) { mix_phase_a(p, l, lds); if (PROBE_MIX2 == 1) { __syncthreads(); mix_phase_a(p, l, lds); } }
        SEAM();
        if (IN()) { mix_phase_b(p, l, lds); if (PROBE_MIX2 == 2 || (PROBE_MIX2 == 3 && blockIdx.x < 32) || (PROBE_MIX2 == 4 && blockIdx.x >= 32)) { __syncthreads(); mix_phase_b(p, l, lds); } }
        SEAM();
        if (IN()) {
            pg8::Gemm g{(const bf16_t*)(ws + WS_MIX), (const bf16_t*)(wl + W_OUT_OFF), NPROMPT, DM, DM}; pg8::StaticOrder S; S.init(NPROMPT, DM, G, bid_opaque());
            EpiRes E{(bf16_t*)(ws + WS_XB), ssq + (size_t)(2 * l + 1) * MP, nullptr};
            pg8::gemm_phase<EpiRes>(lds, g, S, E);
            if (PROBE_ND == 1) { __syncthreads(); EpiNull EN{(float*)(ws + WS_LB) + 8192}; pg8::gemm_phase<EpiNull>(lds, g, S, EN); }
            if (PROBE_ND == 2) sample_tail<DM>(lds, (const bf16_t*)(ws + WS_MIX), (const bf16_t*)(wl + W_OUT_OFF), (float*)(ws + WS_X), (bf16_t*)(ws + WS_XB), ssq + (size_t)(2 * l + 1) * MP, nullptr, true);
        }
        SEAM();
        if (IN()) {
            pg8::Gemm g{(const bf16_t*)(ws + WS_XB), (const bf16_t*)(wl + W_GU_OFF), MP, 2 * FFW, DM}; pg8::StaticOrder S; S.init(MP, 2 * FFW, G, bid_opaque());
            EpiGU E{(bf16_t*)(ws + WS_ACT), ssq + (size_t)(2 * l + 1) * MP};
            pg8::gemm_phase<EpiGU>(lds, g, S, E);
            if (l + 1 < DEPTH) {
                const int nfull = S.nwg % G, c = blockIdx.x;
                if (nfull != 0 && c >= nfull) convert_weights(p, lds, l + 1, (c - nfull) * 8 + __builtin_amdgcn_readfirstlane((int)(threadIdx.x >> 6)), (G - nfull) * 8, 0, CVT_SPLIT);
                else if (nfull == 0) convert_weights(p, lds, l + 1, c * 8 + __builtin_amdgcn_readfirstlane((int)(threadIdx.x >> 6)), G * 8, 0, CVT_SPLIT);
            }
            if (PROBE_IN2 == 2) { __syncthreads(); pg8::gemm_phase<EpiGU>(lds, g, S, E); }
        }
        SEAM();
        if (IN()) {
            pg8::Gemm g{(const bf16_t*)(ws + WS_ACT), (const bf16_t*)(wl + W_DN_OFF), NPROMPT, DM, FFW}; pg8::StaticOrder S; S.init(NPROMPT, DM, G, bid_opaque());
            EpiRes E{(bf16_t*)(ws + WS_XB), ssq + (size_t)(2 * l + 2) * MP, (l == DEPTH - 1) ? p.out : nullptr};
            pg8::gemm_phase<EpiRes>(lds, g, S, E);
            if (PROBE_ND == 1) { __syncthreads(); EpiNull EN{(float*)(ws + WS_LB) + 8192}; pg8::gemm_phase<EpiNull>(lds, g, S, EN); }
            if (PROBE_ND == 2) sample_tail<FFW>(lds, (const bf16_t*)(ws + WS_ACT), (const bf16_t*)(wl + W_DN_OFF), (float*)(ws + WS_X), (bf16_t*)(ws + WS_XB), ssq + (size_t)(2 * l + 2) * MP, nullptr, true);
            sample_tail<FFW>(lds, (const bf16_t*)(ws + WS_ACT), (const bf16_t*)(wl + W_DN_OFF), (float*)(ws + WS_X), (bf16_t*)(ws + WS_XB), ssq + (size_t)(2 * l + 2) * MP, (l == DEPTH - 1) ? p.out : nullptr);
        }
        SEAM();
    }
#undef SEAM
#undef IN
}


#ifndef DBG_STOP
#define DBG_STOP 0
#endif
#ifndef DBG_NANCHK
#define DBG_NANCHK 0
#endif
#ifndef DBG_BUF
#define DBG_BUF 8
#endif
__global__ void dbg_dump(Params p) {
    const size_t n = 45350912; const size_t i0 = (size_t)blockIdx.x * blockDim.x + threadIdx.x, st = (size_t)gridDim.x * blockDim.x;
    for (size_t i = i0; i < n; i += st) {
        float v = 0.f;
        if (DBG_BUF == 1) v = bf2f(((const bf16_t*)(p.ws + WS_U))[i]);
        else if (DBG_BUF == 2) v = ((const float*)(p.ws + WS_LF))[i % ((size_t)MP * 1024)];
        else if (DBG_BUF == 3) v = bf2f(((const bf16_t*)(p.ws + WS_MIX))[i % ((size_t)MR * DM)]);
        else if (DBG_BUF == 4) v = ((const float*)(p.ws + WS_X))[i % ((size_t)MR * DM)];
        else if (DBG_BUF == 5) v = bf2f(((const bf16_t*)(p.ws + WS_ACT))[i]);
        else if (DBG_BUF == 6) v = bf2f(((const bf16_t*)(p.ws + WS_W))[i]);
        else if (DBG_BUF == 7) { const size_t j = i % ((size_t)NPROMPT * 1024); v = bf2f(((const bf16_t*)(p.ws + WS_MIX))[(j >> 10) * DM + (j & 1023)]); }
        else if (DBG_BUF == 8) { const size_t j = i % ((size_t)NPROMPT * 1024); v = bf2f(((const bf16_t*)(p.ws + WS_MIX))[(j >> 10) * DM + 1024 + (j & 1023)]); }
        else if (DBG_BUF == 9) { const size_t j = i % ((size_t)NSAMP * 1024); v = bf2f(((const bf16_t*)(p.ws + WS_MIX))[(NPROMPT + (j >> 10)) * DM + (j & 1023)]); }
        else if (DBG_BUF == 10) { const size_t j = i % ((size_t)NSAMP * 1024); v = bf2f(((const bf16_t*)(p.ws + WS_MIX))[(NPROMPT + (j >> 10)) * DM + 1024 + (j & 1023)]); }
        if (DBG_NANCHK) v = (fabsf(v) <= 3.0e38f) ? 0.f : 1.0e9f;
        p.out[i] = v;
    }
}
#ifndef N_LAUNCH_MODE
#define N_LAUNCH_MODE 1
#endif
extern "C" void kernel_launch(void* const* d_in, const int* in_sizes, int n_in, void* d_out, int out_size, void* d_ws, size_t ws_size, hipStream_t stream) {
    static int grid = 0;
    if (grid == 0) {
        if (n_in != 18 || ws_size < WS_END || out_size != 45350912) { fprintf(stderr, "kernel_launch: unexpected shapes: n_in %d out %d ws %zu\n", n_in, out_size, ws_size); grid = -1; return; }
        int dev = 0, cus = 0, per_cu = 0;
        hipGetDevice(&dev); hipDeviceGetAttribute(&cus, hipDeviceAttributeMultiprocessorCount, dev);
        if (hipFuncSetAttribute((const void*)fwd_mega, hipFuncAttributeMaxDynamicSharedMemorySize, LDS_BYTES) != hipSuccess) { fprintf(stderr, "kernel_launch: hipFuncSetAttribute failed\n"); grid = -1; return; }
        if (hipOccupancyMaxActiveBlocksPerMultiprocessor(&per_cu, (const void*)fwd_mega, 512, LDS_BYTES) != hipSuccess || per_cu < 1) { fprintf(stderr, "kernel_launch: occupancy query says %d\n", per_cu); per_cu = 1; }
        (void)hipGetLastError();
        grid = cus * 1;
        fprintf(stderr, "kernel_launch: grid %d (per_cu %d)\n", grid, per_cu);
    }
    if (grid < 0) return;
    Params p{};
    p.x_prompt = (const float*)d_in[0]; p.x_sample = (const float*)d_in[1]; p.cache_k = (const float*)d_in[2]; p.cache_v = (const float*)d_in[3]; p.state = (const float*)d_in[4];
    p.norm_mix = (const float*)d_in[5]; p.w_in = (const float*)d_in[6]; p.lower_bounds = (const float*)d_in[7]; p.hgrn_norm = (const float*)d_in[8]; p.q_norm = (const float*)d_in[9];
    p.k_norm = (const float*)d_in[10]; p.sinks = (const float*)d_in[11]; p.rel_bias = (const float*)d_in[12]; p.w_out = (const float*)d_in[13]; p.norm_ffn = (const float*)d_in[14];
    p.w_gate = (const float*)d_in[15]; p.w_up = (const float*)d_in[16]; p.w_down = (const float*)d_in[17];
    p.out = (float*)d_out; p.ws = (unsigned char*)d_ws;
#if N_LAUNCH_MODE == 1
    p.ph_lo = 0; p.ph_hi = 25;
    void* args[] = {&p};
    hipError_t e = hipLaunchCooperativeKernel((const void*)fwd_mega, dim3(grid), dim3(512), args, LDS_BYTES, stream);
    if (e != hipSuccess) fprintf(stderr, "cooperative launch failed: %s (grid %d)\n", hipGetErrorString(e), grid);
#else
    const int nph = DBG_STOP ? DBG_STOP : 25;
    for (int ph = 0; ph < nph; ++ph) { p.ph_lo = ph; p.ph_hi = ph + 1; hipLaunchKernelGGL(fwd_mega, dim3(grid), dim3(512), LDS_BYTES, stream, p); }
    if (DBG_STOP) hipLaunchKernelGGL(dbg_dump, dim3(2048), dim3(256), 0, stream, p);
#endif
}
```
